# Optimizing an MI355X kernel written in HIP

```python
import math
import jax, jax.numpy as jnp
from jax import lax
import numpy as np

D_MODEL = 2048
BATCH = 1
SEQ = 8192
DEPTH = 4

HEAD_DIM = 128
N_SELF_HEADS = 12
N_MEM_HEADS = 4
SELF_WIDTH = N_SELF_HEADS * HEAD_DIM
MEM_WIDTH = N_MEM_HEADS * HEAD_DIM
IN_WIDTH = 3 * SELF_WIDTH + MEM_WIDTH
N_MEM = 256
D_FF = 5632
MOBA_BLOCK = 256
MOBA_TOP_K = 3
MOBA_Q_CHUNK = 64
DILATED_CONFIGS = ((128, 1), (512, 4), (2048, 16))
HEADS_PER_DIL_GROUP = N_SELF_HEADS // len(DILATED_CONFIGS)
N_MIXERS = 2
RMS_EPS = 1e-6
NEG_INF = -1e30

kernel_name = "hybrid_moba_dilated_macaron_trunk"


def rmsnorm(x, g):
    xf = x.astype(jnp.float32)
    y = xf * lax.rsqrt(jnp.mean(xf * xf, axis=-1, keepdims=True) + RMS_EPS)
    return (y * g.astype(jnp.float32)).astype(x.dtype)


def swiglu(x, w_in, w_out):
    gate, up = jnp.split(x @ w_in, 2, axis=-1)
    return (jax.nn.silu(gate) * up) @ w_out


def alibi_slopes(n):
    return jnp.exp2(-8.0 * jnp.arange(1, n + 1, dtype=jnp.float32) / n)


def moba_attention(q, k, v, slopes):
    B, S, H, dh = q.shape
    nb = -(-S // MOBA_BLOCK)
    Sp = nb * MOBA_BLOCK
    pad = ((0, 0), (0, Sp - S), (0, 0), (0, 0))
    q, k, v = [jnp.pad(a, pad).transpose(0, 2, 1, 3) for a in (q, k, v)]
    scale = HEAD_DIM ** -0.5
    kb = k.reshape(B, H, nb, MOBA_BLOCK, dh)
    vb = v.reshape(B, H, nb, MOBA_BLOCK, dh)
    k_mean = jnp.mean(kb.astype(jnp.float32), axis=3)
    gate = jnp.einsum('bhsd,bhnd->bhsn', q.astype(jnp.float32), k_mean)
    q_block = jnp.arange(Sp) // MOBA_BLOCK
    past = jnp.arange(nb)[None, :] < q_block[:, None]
    gate = jnp.where(past, gate, NEG_INF)
    top_k = min(MOBA_TOP_K, nb)
    _, sel = lax.top_k(gate, top_k)
    sel_valid = sel < q_block[:, None]

    n_chunks = Sp // MOBA_Q_CHUNK
    QC = MOBA_Q_CHUNK
    q_c = q.reshape(B, H, n_chunks, QC, dh).transpose(2, 0, 1, 3, 4)
    sel_c = sel.reshape(B, H, n_chunks, QC, top_k).transpose(2, 0, 1, 3, 4)
    val_c = sel_valid.reshape(B, H, n_chunks, QC, top_k).transpose(2, 0, 1, 3, 4)
    starts = jnp.arange(n_chunks, dtype=jnp.int32) * QC
    bi = jnp.arange(B)[:, None, None, None]
    hi = jnp.arange(H)[None, :, None, None]
    offs = jnp.arange(MOBA_BLOCK, dtype=jnp.int32)
    n_sel = top_k * MOBA_BLOCK

    def chunk(args):
        qc, sc, vc, t0 = args
        t = t0 + jnp.arange(QC, dtype=jnp.int32)
        k_sel = kb[bi, hi, sc]
        v_sel = vb[bi, hi, sc]
        s_sel = jnp.einsum('bhqd,bhqkjd->bhqkj', qc, k_sel).astype(jnp.float32) * scale
        key_pos = sc[..., None] * MOBA_BLOCK + offs
        dist = (t[:, None, None] - key_pos).astype(jnp.float32)
        s_sel = s_sel - slopes[:, None, None, None] * dist
        s_sel = jnp.where(vc[..., None], s_sel, NEG_INF)
        own = t0 // MOBA_BLOCK
        k_own = lax.dynamic_index_in_dim(kb, own, axis=2, keepdims=False)
        v_own = lax.dynamic_index_in_dim(vb, own, axis=2, keepdims=False)
        d_own = t[:, None] - (own * MOBA_BLOCK + offs)[None, :]
        s_own = jnp.einsum('bhqd,bhjd->bhqj', qc, k_own).astype(jnp.float32) * scale
        s_own = s_own - slopes[:, None, None] * d_own.astype(jnp.float32)
        s_own = jnp.where(d_own >= 0, s_own, NEG_INF)
        scores = jnp.concatenate([s_sel.reshape(B, H, QC, n_sel), s_own], axis=-1)
        p = jax.nn.softmax(scores, axis=-1).astype(v.dtype)
        p_sel = p[..., :n_sel].reshape(B, H, QC, top_k, MOBA_BLOCK)
        p_own = p[..., n_sel:]
        return (jnp.einsum('bhqkj,bhqkjd->bhqd', p_sel, v_sel)
                + jnp.einsum('bhqj,bhjd->bhqd', p_own, v_own))

    out = lax.map(chunk, (q_c, sel_c, val_c, starts))
    out = out.transpose(1, 0, 3, 2, 4).reshape(B, Sp, H, dh)
    return out[:, :S]


def dilated_group(q, k, v, slopes, window, dilation):
    B, S, Hg, dh = q.shape
    L = window // dilation
    span = L * dilation
    Sp = -(-S // span) * span
    n = Sp // dilation
    nblk = n // L
    scale = HEAD_DIM ** -0.5

    def to_blocks(a):
        a = jnp.pad(a, ((0, 0), (0, Sp - S), (0, 0), (0, 0)))
        a = a.reshape(B, n, dilation, Hg, dh).transpose(0, 2, 3, 1, 4)
        return a.reshape(B, dilation, Hg, nblk, L, dh)

    def with_prev(a):
        prev = jnp.pad(a[:, :, :, :-1], ((0, 0), (0, 0), (0, 0), (1, 0), (0, 0), (0, 0)))
        return jnp.concatenate([prev, a], axis=4)

    qb = to_blocks(q)
    k2 = with_prev(to_blocks(k))
    v2 = with_prev(to_blocks(v))
    scores = jnp.einsum('brhcqd,brhckd->brhcqk', qb, k2).astype(jnp.float32) * scale
    delta = L + jnp.arange(L)[:, None] - jnp.arange(2 * L)[None, :]
    key_idx = jnp.arange(nblk)[:, None] * L - L + jnp.arange(2 * L)[None, :]
    mask = ((delta >= 0) & (delta <= L))[None, :, :] & (key_idx >= 0)[:, None, :]
    scores = scores - slopes[:, None, None, None] * (delta * dilation).astype(jnp.float32)
    scores = jnp.where(mask, scores, NEG_INF)
    lse = jax.nn.logsumexp(scores, axis=-1)
    p = jnp.exp(scores - lse[..., None]).astype(v.dtype)
    out = jnp.einsum('brhcqk,brhckd->brhcqd', p, v2)
    out = out.reshape(B, dilation, Hg, n, dh).transpose(0, 3, 1, 2, 4).reshape(B, Sp, Hg, dh)
    lse = lse.reshape(B, dilation, Hg, n).transpose(0, 3, 1, 2).reshape(B, Sp, Hg)
    return out[:, :S], lse[:, :S]


def dilated_attention(q, k, v, slopes):
    outs, lses = [], []
    for g, (window, dilation) in enumerate(DILATED_CONFIGS):
        hs = slice(g * HEADS_PER_DIL_GROUP, (g + 1) * HEADS_PER_DIL_GROUP)
        o, l = dilated_group(q[:, :, hs], k[:, :, hs], v[:, :, hs], slopes[hs], window, dilation)
        outs.append(o)
        lses.append(l)
    alpha = jax.nn.softmax(jnp.stack(lses, axis=0), axis=0)
    return jnp.concatenate(
        [alpha[g][..., None].astype(outs[g].dtype) * outs[g] for g in range(len(outs))], axis=2)


def token_mixing(h, mem_n, w_in, w_mem_kv, w_out, kind, slopes):
    B, S, _ = h.shape
    proj = h @ w_in
    q = proj[..., :SELF_WIDTH].reshape(B, S, N_SELF_HEADS, HEAD_DIM)
    k = proj[..., SELF_WIDTH:2 * SELF_WIDTH].reshape(B, S, N_SELF_HEADS, HEAD_DIM)
    v = proj[..., 2 * SELF_WIDTH:3 * SELF_WIDTH].reshape(B, S, N_SELF_HEADS, HEAD_DIM)
    qm = proj[..., 3 * SELF_WIDTH:].reshape(B, S, N_MEM_HEADS, HEAD_DIM)
    if kind == 0:
        self_out = moba_attention(q, k, v, slopes)
    else:
        self_out = dilated_attention(q, k, v, slopes)
    km, vm = jnp.split(mem_n @ w_mem_kv, 2, axis=-1)
    km = km.reshape(B, N_MEM, N_MEM_HEADS, HEAD_DIM)
    vm = vm.reshape(B, N_MEM, N_MEM_HEADS, HEAD_DIM)
    s = jnp.einsum('bshd,bmhd->bhsm', qm, km).astype(jnp.float32) * (HEAD_DIM ** -0.5)
    p = jax.nn.softmax(s, axis=-1).astype(vm.dtype)
    mem_out = jnp.einsum('bhsm,bmhd->bshd', p, vm)
    cat = jnp.concatenate([self_out.reshape(B, S, SELF_WIDTH), mem_out.reshape(B, S, MEM_WIDTH)], axis=-1)
    return cat @ w_out


def setup_inputs(seed: int = 0) -> dict:
    key = jax.random.key(seed)
    ks = jax.random.split(key, 10)
    f32 = jnp.float32
    x = jax.random.normal(ks[0], (BATCH, SEQ, D_MODEL), f32)
    mem = jax.random.normal(ks[1], (BATCH, N_MEM, D_MODEL), f32)
    g_pre = 1.0 + 0.05 * jax.random.normal(ks[2], (DEPTH, 3, D_MODEL), f32)
    g_post = 1.0 + 0.05 * jax.random.normal(ks[3], (DEPTH, 3, D_MODEL), f32)
    g_mem = 1.0 + 0.05 * jax.random.normal(ks[4], (DEPTH, D_MODEL), f32)
    w_ffn_in = jax.random.normal(ks[5], (DEPTH, 2, D_MODEL, 2 * D_FF), f32) * D_MODEL ** -0.5
    w_ffn_out = jax.random.normal(ks[6], (DEPTH, 2, D_FF, D_MODEL), f32) * D_FF ** -0.5
    w_in = jax.random.normal(ks[7], (DEPTH, D_MODEL, IN_WIDTH), f32) * D_MODEL ** -0.5
    w_mem_kv = jax.random.normal(ks[8], (DEPTH, D_MODEL, 2 * MEM_WIDTH), f32) * D_MODEL ** -0.5
    w_out = jax.random.normal(ks[9], (DEPTH, SELF_WIDTH + MEM_WIDTH, D_MODEL), f32) * (SELF_WIDTH + MEM_WIDTH) ** -0.5
    return {"x": x, "mem": mem, "g_pre": g_pre, "g_post": g_post, "g_mem": g_mem,
            "w_ffn_in": w_ffn_in, "w_ffn_out": w_ffn_out, "w_in": w_in,
            "w_mem_kv": w_mem_kv, "w_out": w_out}


def reference(x, mem, g_pre, g_post, g_mem, w_ffn_in, w_ffn_out, w_in, w_mem_kv, w_out):
    slopes = alibi_slopes(N_SELF_HEADS)
    for layer in range(DEPTH):
        kind = layer % N_MIXERS
        f = swiglu(rmsnorm(x, g_pre[layer, 0]), w_ffn_in[layer, 0], w_ffn_out[layer, 0])
        x = x + 0.5 * rmsnorm(f, g_post[layer, 0])
        mem_n = rmsnorm(mem, g_mem[layer])
        m = token_mixing(rmsnorm(x, g_pre[layer, 1]), mem_n, w_in[layer], w_mem_kv[layer],
                         w_out[layer], kind, slopes)
        x = x + rmsnorm(m, g_post[layer, 1])
        f = swiglu(rmsnorm(x, g_pre[layer, 2]), w_ffn_in[layer, 1], w_ffn_out[layer, 1])
        x = x + 0.5 * rmsnorm(f, g_post[layer, 2])
    return x
```

```cpp
#include <hip/hip_runtime.h>
#include <cstdio>
#include <cstdint>
#include <cmath>
namespace pg8 {
#define PG8_LAS __attribute__((address_space(3)))
typedef unsigned short bf16_t;
typedef short bf16x8 __attribute__((ext_vector_type(8)));
typedef float f32x4 __attribute__((ext_vector_type(4)));
typedef unsigned u32x4 __attribute__((ext_vector_type(4)));
constexpr int BM = 256, BK = 64, HALF = 128, HTB = HALF * BK * 2  , STAGE_BYTES = 8 * HTB, NXCD = 8, WGM = 8;

__host__ __device__ __forceinline__ int lds_byte(int r, int c) { const int st = (r >> 4) * 2 + (c >> 5), rr = r & 15, cc = c & 31, ob = rr * 64 + cc * 2; return st * 1024 + (ob ^ (((ob >> 9) & 1) << 5)); }
__host__ __device__ __forceinline__ void stage_rc(int b, int& R, int& C) { const int st = b / 1024, sb = b % 1024, swz = sb ^ (((sb >> 9) & 1) << 5); R = (st >> 1) * 16 + swz / 64; C = (st & 1) * 32 + (swz % 64) / 2; }
__host__ __device__ __forceinline__ int perm32(int rho) { const int n = rho >> 4, i = rho & 15; return 8 * (i >> 2) + 4 * n + (i & 3); }

struct Unit { int pm, pn; };
struct Gemm { const bf16_t* A; const bf16_t* Bt; int M, N, K; };

struct StaticOrder {
    int nM, nN, nwg, G, c;
    __host__ __device__ void init(int M, int N, int G_, int c_) { nM = M / BM; nN = N / BM; nwg = nM * nN; G = G_; c = c_; }
    __host__ __device__ bool next(int i, Unit& u) const {
        const long L = (long)i * G + c; if (L >= nwg) return false;
        int wgid = (int)L; { const int q = nwg / NXCD, r = nwg % NXCD, xcd = wgid % NXCD, off = wgid / NXCD; wgid = (xcd < r ? xcd * (q + 1) : r * (q + 1) + (xcd - r) * q) + off; }
        const int nig = WGM * nN, gid = wgid / nig, fm = gid * WGM, gsz = (nM - fm) < WGM ? (nM - fm) : WGM;
        u.pm = fm + ((wgid % nig) % gsz); u.pn = (wgid % nig) / gsz; return true;
    }
    __device__ __forceinline__ void a_ready(const Unit&) const {}
    __device__ __forceinline__ void done(const Unit&) const {}
};

__device__ __forceinline__ unsigned cvt_pk_bf16(float lo, float hi) { unsigned r; asm volatile("v_cvt_pk_bf16_f32 %0, %1, %2" : "=v"(r) : "v"(lo), "v"(hi)); return r; }
typedef float f32x2 __attribute__((ext_vector_type(2)));
struct XOrder {
    int nM, nN, nwg, G, c, extra;
    __host__ __device__ void init(int M, int N, int G_, int c_, int extra_) { nM = M / BM; nN = N / BM; nwg = nM * nN; G = G_; c = c_; extra = extra_; }
    __host__ __device__ bool next(int i, Unit& u) const {
        const long L = (long)i * G + c;
        if (L >= nwg) { const long e = L - nwg; if (e >= extra) return false; u.pm = nM; u.pn = nN + (int)e; return true; }
        int wgid = (int)L; { const int q = nwg / NXCD, r = nwg % NXCD, xcd = wgid % NXCD, off = wgid / NXCD; wgid = (xcd < r ? xcd * (q + 1) : r * (q + 1) + (xcd - r) * q) + off; }
        const int nig = WGM * nN, gid = wgid / nig, fm = gid * WGM, gsz = (nM - fm) < WGM ? (nM - fm) : WGM;
        u.pm = fm + ((wgid % nig) % gsz); u.pn = (wgid % nig) / gsz; return true;
    }
    __device__ __forceinline__ void a_ready(const Unit&) const {}
    __device__ __forceinline__ void done(const Unit&) const {}
};

struct EpiF32 {
    static constexpr bool PERM = false, AFTER_DRAIN = false;
    float* C; int ldc;
    __device__ __forceinline__ void operator()(const f32x4 (&acc)[2][2][4][2], const Unit& u, int wr, int wc, int fr, int fq) const {
        const int row0 = u.pm * BM + wr * 64 + fr, col0 = u.pn * BM + wc * 32 + 4 * fq;
#pragma unroll
        for (int ai = 0; ai < 2; ++ai)
#pragma unroll
            for (int m = 0; m < 4; ++m) { float* rowp = C + (size_t)(row0 + ai * HALF + m * 16) * ldc + col0;
#pragma unroll
                for (int bj = 0; bj < 2; ++bj)
#pragma unroll
                    for (int n = 0; n < 2; ++n) *(f32x4*)(rowp + bj * HALF + n * 16) = acc[ai][bj][m][n]; }
    }
};
struct EpiBf16 {
    static constexpr bool PERM = true, AFTER_DRAIN = false;
    bf16_t* O; int ldc;
    __device__ __forceinline__ void operator()(const f32x4 (&acc)[2][2][4][2], const Unit& u, int wr, int wc, int fr, int fq) const {
        const int row0 = u.pm * BM + wr * 64 + fr, col0 = u.pn * BM + wc * 32 + 8 * fq;
#pragma unroll
        for (int ai = 0; ai < 2; ++ai)
#pragma unroll
            for (int m = 0; m < 4; ++m) { bf16_t* rowp = O + (size_t)(row0 + ai * HALF + m * 16) * ldc + col0;
#pragma unroll
                for (int bj = 0; bj < 2; ++bj) { const f32x4 v0 = acc[ai][bj][m][0], v1 = acc[ai][bj][m][1];
                    u32x4 w; w.x = cvt_pk_bf16(v0[0], v0[1]); w.y = cvt_pk_bf16(v0[2], v0[3]); w.z = cvt_pk_bf16(v1[0], v1[1]); w.w = cvt_pk_bf16(v1[2], v1[3]);
                    *(u32x4*)(rowp + bj * HALF) = w; } }
    }
};
__device__ __forceinline__ float silu_mul(float g, float u) { return g * u * __builtin_amdgcn_rcpf(1.0f + __builtin_amdgcn_exp2f(-1.4426950408889634f * g)); }
struct EpiSwiGLU {
    static constexpr bool PERM = true, AFTER_DRAIN = false;
    bf16_t* O; int ldc;
    __device__ __forceinline__ void operator()(const f32x4 (&acc)[2][2][4][2], const Unit& u, int wr, int wc, int fr, int fq) const {
        const int row0 = u.pm * BM + wr * 64 + fr, col0 = u.pn * HALF + wc * 32 + 8 * fq;
#pragma unroll
        for (int ai = 0; ai < 2; ++ai)
#pragma unroll
            for (int m = 0; m < 4; ++m) { bf16_t* rowp = O + (size_t)(row0 + ai * HALF + m * 16) * ldc + col0;
                const f32x4 g0 = acc[ai][0][m][0], g1 = acc[ai][0][m][1], u0 = acc[ai][1][m][0], u1 = acc[ai][1][m][1];
                u32x4 w; w.x = cvt_pk_bf16(silu_mul(g0[0], u0[0]), silu_mul(g0[1], u0[1])); w.y = cvt_pk_bf16(silu_mul(g0[2], u0[2]), silu_mul(g0[3], u0[3]));
                w.z = cvt_pk_bf16(silu_mul(g1[0], u1[0]), silu_mul(g1[1], u1[1])); w.w = cvt_pk_bf16(silu_mul(g1[2], u1[2]), silu_mul(g1[3], u1[3]));
                *(u32x4*)rowp = w; }
    }
};

template <class Epi, class Sched, bool ALIGN_EPI = false, bool SP2 = false>
__device__ __forceinline__ void gemm_phase(PG8_LAS unsigned char* lds, const Gemm g, const Sched& S, const Epi& E) {
    int tid_ = threadIdx.x; asm volatile("" : "+v"(tid_));
    const int tid = tid_, wid = __builtin_amdgcn_readfirstlane(tid >> 6), lane = tid & 63, wr = wid >> 2, wc = wid & 3, fr = lane & 15, fq = lane >> 4;
    const int K = g.K, nt = K / BK;
    unsigned voffA[2], voffB[2];
#pragma unroll
    for (int i = 0; i < 2; ++i) { int R, C; stage_rc(tid * 16 + i * 8192, R, C); const int Rb = Epi::PERM ? ((R & ~31) + perm32(R & 31)) : R;
        voffA[i] = (unsigned)(R * K + C) * 2u; voffB[i] = (unsigned)(Rb * K + C) * 2u; }
    const size_t kstep = (size_t)(BK * 2);
    const size_t hstep = (size_t)HALF * K * 2;
    const size_t tstep = 2 * hstep;
    const unsigned ldsw = (unsigned)wid * 1024u;
    const int aoff = lds_byte(wr * 64 + fr, fq * 8), boff = lds_byte(wc * 32 + fr, fq * 8);
#define PG8_SA(b, h) (((b) * 2 + (h)) * HTB)
#define PG8_SB(b, h) ((4 + (b) * 2 + (h)) * HTB)
#define PG8_STAGE(bufoff, gbase, voff) do { _Pragma("unroll") for (int _i = 0; _i < 2; ++_i) \
        __builtin_amdgcn_global_load_lds((const unsigned*)((const char*)(gbase) + (voff)[_i]), (PG8_LAS unsigned*)(lds + (bufoff) + ldsw + _i * 8192), 16, 0, 0); } while (0)
#define PG8_LDA(dst, b, h) do { _Pragma("unroll") for (int m = 0; m < 4; ++m) _Pragma("unroll") for (int k = 0; k < 2; ++k) dst[m][k] = *(const PG8_LAS bf16x8*)(lds + PG8_SA(b, h) + aoff + m * 2048 + k * 1024); } while (0)
#define PG8_LDB(dst, b, h) do { _Pragma("unroll") for (int n = 0; n < 2; ++n) _Pragma("unroll") for (int k = 0; k < 2; ++k) dst[n][k] = *(const PG8_LAS bf16x8*)(lds + PG8_SB(b, h) + boff + n * 2048 + k * 1024); } while (0)
#define PG8_MMA(ai, bj, At, Bt) do { __builtin_amdgcn_s_setprio(1); _Pragma("unroll") for (int m = 0; m < 4; ++m) _Pragma("unroll") for (int n = 0; n < 2; ++n) _Pragma("unroll") for (int k = 0; k < 2; ++k) \
        acc[ai][bj][m][n] = __builtin_amdgcn_mfma_f32_16x16x32_bf16(Bt[n][k], At[m][k], acc[ai][bj][m][n], 0, 0, 0); __builtin_amdgcn_s_setprio(0); } while (0)
#define PG8_WAIT_V(n) asm volatile("s_waitcnt vmcnt(" #n ")" ::: "memory")
#define PG8_WAIT_L(n) asm volatile("s_waitcnt lgkmcnt(" #n ")" ::: "memory")
#define PG8_BAR __builtin_amdgcn_s_barrier()
#define PG8_SCHED __builtin_amdgcn_sched_barrier(0)
    Unit cur, nxt; int ui = 0;
    if (!S.next(0, cur)) return;
    f32x4 acc[2][2][4][2];
#pragma unroll
    for (int a = 0; a < 2; ++a)
#pragma unroll
        for (int b = 0; b < 2; ++b)
#pragma unroll
            for (int m = 0; m < 4; ++m)
#pragma unroll
                for (int n = 0; n < 2; ++n) acc[a][b][m][n] = (f32x4){0.f, 0.f, 0.f, 0.f};
    bf16x8 At[4][2], B0[2][2], B1[2][2];
    const char* cA = (const char*)g.A + (size_t)cur.pm * tstep; const char* cB = (const char*)g.Bt + (size_t)cur.pn * tstep;
    S.a_ready(cur);
    if constexpr (SP2) {
        PG8_STAGE(PG8_SB(0, 0), cB, voffB); PG8_STAGE(PG8_SB(0, 1), cB + hstep, voffB); PG8_STAGE(PG8_SA(0, 0), cA, voffA); PG8_STAGE(PG8_SA(0, 1), cA + hstep, voffA);
        if (wr == 1) PG8_BAR;
        PG8_WAIT_V(2); PG8_BAR;
        PG8_STAGE(PG8_SB(1, 0), cB + kstep, voffB); PG8_STAGE(PG8_SA(1, 0), cA + kstep, voffA); PG8_STAGE(PG8_SB(1, 1), cB + hstep + kstep, voffB);
        PG8_WAIT_V(6); PG8_BAR;
    } else {
        PG8_STAGE(PG8_SB(0, 0), cB, voffB); PG8_STAGE(PG8_SA(0, 0), cA, voffA); PG8_STAGE(PG8_SB(0, 1), cB + hstep, voffB); PG8_STAGE(PG8_SA(0, 1), cA + hstep, voffA);
        if (wr == 1) PG8_BAR;
        PG8_WAIT_V(4); PG8_BAR;
        PG8_STAGE(PG8_SB(1, 0), cB + kstep, voffB); PG8_STAGE(PG8_SA(1, 0), cA + kstep, voffA); PG8_STAGE(PG8_SB(1, 1), cB + hstep + kstep, voffB);
        PG8_WAIT_V(6); PG8_BAR;
    }
    for (;;) {
        const bool has_next = S.next(ui + 1, nxt);
        const char* nA = has_next ? (const char*)g.A + (size_t)nxt.pm * tstep : cA; const char* nB = has_next ? (const char*)g.Bt + (size_t)nxt.pn * tstep : cB;
        for (int t = 0; t < nt; t += 2) {
            const bool last = (t == nt - 2);
            const char* a1 = cA + (size_t)(t + 1) * kstep;
            const char* a2 = last ? nA : cA + (size_t)(t + 2) * kstep; const char* b2 = last ? nB : cB + (size_t)(t + 2) * kstep;
            const char* a3 = a2 + kstep; const char* b3 = b2 + kstep;
            if (last && has_next) S.a_ready(nxt);
            if constexpr (SP2) {
            PG8_LDB(B0, 0, 0); PG8_LDB(B1, 0, 1); PG8_SCHED; PG8_LDA(At, 0, 0); PG8_STAGE(PG8_SA(1, 1), a1 + hstep, voffA);
            PG8_WAIT_V(8); PG8_WAIT_L(0); PG8_BAR; PG8_MMA(0, 0, At, B0); PG8_MMA(0, 1, At, B1); PG8_BAR; PG8_SCHED;
            PG8_LDA(At, 0, 1); PG8_STAGE(PG8_SB(0, 0), b2, voffB); PG8_STAGE(PG8_SB(0, 1), b2 + hstep, voffB); PG8_STAGE(PG8_SA(0, 0), a2, voffA);
            PG8_WAIT_V(8); PG8_WAIT_L(0); PG8_BAR; PG8_MMA(1, 0, At, B0); PG8_MMA(1, 1, At, B1); PG8_BAR; PG8_SCHED;
            PG8_LDB(B0, 1, 0); PG8_LDB(B1, 1, 1); PG8_SCHED; PG8_LDA(At, 1, 0); PG8_STAGE(PG8_SA(0, 1), a2 + hstep, voffA);
            PG8_WAIT_V(8); PG8_WAIT_L(0); PG8_BAR; PG8_MMA(0, 0, At, B0); PG8_MMA(0, 1, At, B1); PG8_BAR; PG8_SCHED;
            PG8_LDA(At, 1, 1); PG8_STAGE(PG8_SB(1, 0), b3, voffB); PG8_STAGE(PG8_SB(1, 1), b3 + hstep, voffB); PG8_STAGE(PG8_SA(1, 0), a3, voffA);
            PG8_WAIT_V(8); PG8_WAIT_L(0); PG8_BAR; PG8_MMA(1, 0, At, B0); PG8_MMA(1, 1, At, B1); PG8_BAR; PG8_SCHED;
            } else {
            PG8_LDB(B0, 0, 0); PG8_SCHED; PG8_LDA(At, 0, 0); PG8_STAGE(PG8_SA(1, 1), a1 + hstep, voffA);
            PG8_WAIT_L(8); PG8_BAR; PG8_WAIT_L(0); PG8_MMA(0, 0, At, B0); PG8_BAR; PG8_SCHED;
            PG8_LDB(B1, 0, 1); PG8_STAGE(PG8_SB(0, 0), b2, voffB);
            PG8_BAR; PG8_WAIT_L(0); PG8_MMA(0, 1, At, B1); PG8_BAR;
            PG8_LDA(At, 0, 1); PG8_STAGE(PG8_SA(0, 0), a2, voffA);
            PG8_BAR; PG8_WAIT_L(0); PG8_MMA(1, 0, At, B0); PG8_BAR; PG8_SCHED;
            PG8_STAGE(PG8_SB(0, 1), b2 + hstep, voffB);
            PG8_WAIT_V(6); PG8_BAR; PG8_MMA(1, 1, At, B1); PG8_BAR;
            PG8_LDB(B0, 1, 0); PG8_SCHED; PG8_LDA(At, 1, 0); PG8_STAGE(PG8_SA(0, 1), a2 + hstep, voffA);
            PG8_WAIT_L(8); PG8_BAR; PG8_WAIT_L(0); PG8_MMA(0, 0, At, B0); PG8_BAR; PG8_SCHED;
            PG8_LDB(B1, 1, 1); PG8_STAGE(PG8_SB(1, 0), b3, voffB);
            PG8_BAR; PG8_WAIT_L(0); PG8_MMA(0, 1, At, B1); PG8_BAR;
            PG8_LDA(At, 1, 1); PG8_STAGE(PG8_SA(1, 0), a3, voffA);
            PG8_BAR; PG8_WAIT_L(0); PG8_MMA(1, 0, At, B0); PG8_BAR; PG8_SCHED;
            PG8_STAGE(PG8_SB(1, 1), b3 + hstep, voffB);
            PG8_WAIT_V(6); PG8_BAR; PG8_MMA(1, 1, At, B1); PG8_BAR;
            }
        }
        if constexpr (ALIGN_EPI) { if (wr == 0) PG8_BAR; }
        if constexpr (!Epi::AFTER_DRAIN) { E(acc, cur, wr, wc, fr, fq); S.done(cur); }
        if (!has_next) break;
#pragma unroll
        for (int a = 0; a < 2; ++a)
#pragma unroll
            for (int b = 0; b < 2; ++b)
#pragma unroll
                for (int m = 0; m < 4; ++m)
#pragma unroll
                    for (int n = 0; n < 2; ++n) acc[a][b][m][n] = (f32x4){0.f, 0.f, 0.f, 0.f};
        cur = nxt; cA = nA; cB = nB; ++ui;
        if constexpr (ALIGN_EPI) { if (wr == 1) PG8_BAR; }
    }
    PG8_WAIT_V(0);
    if constexpr (!ALIGN_EPI) { if (wr == 0) PG8_BAR; }
    PG8_BAR;
    if constexpr (Epi::AFTER_DRAIN) { E.fused(acc, cur, wr, wc, fr, fq, lds, wid, lane); S.done(cur); }
#undef PG8_SA
#undef PG8_SB
#undef PG8_STAGE
#undef PG8_LDA
#undef PG8_LDB
#undef PG8_MMA
#undef PG8_WAIT_V
#undef PG8_WAIT_L
#undef PG8_BAR
#undef PG8_SCHED
}
}
#define GAS __attribute__((address_space(1)))
#define LAS __attribute__((address_space(3)))
typedef unsigned short bf16;
typedef unsigned v4u __attribute__((ext_vector_type(4)));
typedef float f32x4 __attribute__((ext_vector_type(4)));
typedef short bf16x8 __attribute__((ext_vector_type(8)));
typedef GAS unsigned gu32;
typedef GAS unsigned long long gu64;
#define RLX_AGENT __ATOMIC_RELAXED, __HIP_MEMORY_SCOPE_AGENT
#define LDS_WAIT() asm volatile("s_waitcnt lgkmcnt(0)" ::: "memory")
#define VM_WAIT() asm volatile("s_waitcnt vmcnt(0)" ::: "memory")
__device__ __forceinline__ unsigned long long rt() { return __builtin_amdgcn_s_memrealtime(); }
__device__ __forceinline__ unsigned f2bf(float f) { unsigned u = __builtin_bit_cast(unsigned, f); return (u + 0x7fffu + ((u >> 16) & 1u)) >> 16; }
__device__ __forceinline__ unsigned pk2(float lo, float hi) { return f2bf(lo) | (f2bf(hi) << 16); }

#define XB_TMO      128
#define XB_XCNT(j)  (256  + 64 * (j))
#define XB_XSUB(j)  (1280 + 64 * (j))
#define XB_XGEN(j)  (2304 + 64 * (j))
#define XB_TOP      3328
#define XB_TOPGEN   3392
#define XCD_BAR_WORDS 3456
#define XB_SPIN_CAP (1u << 18)

__device__ __forceinline__ unsigned xb_ld(unsigned* p)              { return __hip_atomic_load(p, __ATOMIC_RELAXED, __HIP_MEMORY_SCOPE_AGENT); }
__device__ __forceinline__ unsigned xb_add(unsigned* p, unsigned v) { return __hip_atomic_fetch_add(p, v, __ATOMIC_RELAXED, __HIP_MEMORY_SCOPE_AGENT); }
__device__ __forceinline__ unsigned xb_xcc_id() { return (unsigned)__builtin_amdgcn_s_getreg((3 << 11) | 20) & 0xFu; }
#define XB_SPIN(cond, bar) do { unsigned _sp = 0; while (cond) { __builtin_amdgcn_s_sleep(1); \
    if ((++_sp & 255u) == 0u) { if (xb_ld(&(bar)[XB_TMO])) break; if (_sp > XB_SPIN_CAP) { atomicAdd(&(bar)[XB_TMO], 1u); break; } } } } while (0)

struct XcdBarrier {
    unsigned* bar; unsigned x;
    volatile LAS unsigned* st;
};

__device__ __forceinline__ XcdBarrier xcd_barrier_post(unsigned* bar, volatile LAS unsigned* st) {
    XcdBarrier b; b.bar = bar; b.x = xb_xcc_id(); b.st = st;
    if (threadIdx.x == 0) (void)xb_add(&bar[XB_XCNT(b.x)], 1u);
    return b;
}
__device__ __forceinline__ void xcd_barrier_complete(unsigned* bar, unsigned x, unsigned& nloc, unsigned& nx) {
    const unsigned G = gridDim.x * gridDim.y * gridDim.z;
    unsigned sum, cnt, mine, sp = 0u;
    for (;;) {
        sum = 0u; cnt = 0u; mine = 0u;
#pragma unroll
        for (unsigned j = 0; j < 16; ++j) { const unsigned c = xb_ld(&bar[XB_XCNT(j)]); sum += c; cnt += (c > 0u) ? 1u : 0u; mine = (j == x) ? c : mine; }
        if (sum == G) break;
        __builtin_amdgcn_s_sleep(1);
        if ((++sp & 255u) == 0u) { if (xb_ld(&bar[XB_TMO])) break; if (sp > XB_SPIN_CAP) { atomicAdd(&bar[XB_TMO], 1u); break; } }
    }
    nloc = mine > 0u ? mine : 1u; nx = cnt > 0u ? cnt : 1u;
}

__device__ __forceinline__ void xcd_barrier(const XcdBarrier& b) {
    asm volatile("s_waitcnt vmcnt(0)" ::: "memory");
    __syncthreads();
    if (threadIdx.x == 0) {
        unsigned* bar = b.bar;
        __builtin_amdgcn_s_waitcnt(0);
        unsigned nloc = b.st[0], nx = b.st[1];
        if (nloc == 0u) { xcd_barrier_complete(bar, b.x, nloc, nx); b.st[0] = nloc; b.st[1] = nx; }
        const unsigned old = xb_add(&bar[XB_XSUB(b.x)], 1u);
        const unsigned gen = old / nloc;
        if (old + 1u == (gen + 1u) * nloc) {
            __builtin_amdgcn_fence(__ATOMIC_RELEASE, "agent");
            asm volatile("s_waitcnt vmcnt(0)" ::: "memory");
            const unsigned og = xb_add(&bar[XB_TOP], 1u);
            const unsigned tg = og / nx;
            if (og + 1u == (tg + 1u) * nx) xb_add(&bar[XB_TOPGEN], 1u);
            else XB_SPIN(xb_ld(&bar[XB_TOPGEN]) == tg, bar);
            __builtin_amdgcn_fence(__ATOMIC_ACQUIRE, "agent");
            xb_add(&bar[XB_XGEN(b.x)], 1u);
            asm volatile("s_waitcnt vmcnt(0)" ::: "memory");
        } else {
            XB_SPIN(xb_ld(&bar[XB_XGEN(b.x)]) == gen, bar);
            __builtin_amdgcn_fence(__ATOMIC_ACQUIRE, "agent");
            asm volatile("s_waitcnt vmcnt(0)" ::: "memory");
        }
    }
    __syncthreads();
}
typedef unsigned v2u __attribute__((ext_vector_type(2)));
__device__ __forceinline__ float bf_lo(unsigned w) { return __uint_as_float(w << 16); }
__device__ __forceinline__ float bf_hi(unsigned w) { return __uint_as_float(w & 0xffff0000u); }

constexpr int NWAVES = 8;
constexpr int SEQ = 8192, DM = 2048, DFF = 5632, DEPTH = 4, NH = 12, HD = 128, NMEM = 256, NMH = 4;
constexpr int SELF_W = NH * HD, IN_W = 3 * SELF_W + NMH * HD, KVW = 2 * NMH * HD;
constexpr int LDP = IN_W + KVW;
constexpr int MROWS = SEQ + NMEM;
constexpr int QCOL = 0, KCOL = SELF_W, VCOL = 2 * SELF_W, QMCOL = 3 * SELF_W, KMCOL = IN_W, VMCOL = IN_W + NMH * HD;
constexpr float RMS_EPS = 1e-6f, SCALE = 0.08838834764831845f;
constexpr int MOBA_BLK = 256, MOBA_NB = SEQ / MOBA_BLK;

constexpr size_t MiB = 1u << 20;
constexpr size_t WS_CTL = 0, CTL_ZERO_BYTES = 1 * MiB;
constexpr size_t WS_KMEAN = 1 * MiB;
constexpr size_t WS_W = 2 * MiB, LW = 164 * MiB;
constexpr size_t LW_IN = 0, LW_OUT = 88 * MiB, LW_QKV = 132 * MiB, LW_O = 156 * MiB;
constexpr size_t WS_H = WS_W + DEPTH * LW;
constexpr size_t WS_A = WS_H + 33 * MiB;
constexpr size_t WS_F = WS_A + 88 * MiB;
constexpr size_t WS_P = WS_F + 64 * MiB;
constexpr size_t WS_CAT = WS_P + 99 * MiB;
constexpr size_t WS_END = WS_CAT + 32 * MiB;
static_assert((size_t)MROWS * DM * 2 == 33 * MiB && (size_t)SEQ * DFF * 2 == 88 * MiB && (size_t)MROWS * LDP * 2 == 99 * MiB && (size_t)2 * DFF * DM * 2 == 44 * MiB && (size_t)LDP * DM * 2 == 24 * MiB, "ws map");
constexpr int CW_BAR = 4096;

constexpr int RING_OFF = 0, RING_BYTES = 131072;
constexpr int LDSCTL_OFF = RING_BYTES, MISC_OFF = LDSCTL_OFF + 320;
constexpr int LDS_BYTES = 147456;

struct Ctx {
    LAS unsigned char* lds;
    int tid, lane, wave, vcu, G;
};

#define WAVE_SYNC() do { asm volatile("s_waitcnt lgkmcnt(0)" ::: "memory"); __builtin_amdgcn_wave_barrier(); asm volatile("" ::: "memory"); } while (0)
__device__ __forceinline__ float wave_sum(float v) {
#pragma unroll
    for (int o = 1; o < 64; o <<= 1) v += __shfl_xor(v, o);
    return v;
}
__device__ __forceinline__ float wave_max(float v) {
#pragma unroll
    for (int o = 1; o < 64; o <<= 1) v = fmaxf(v, __shfl_xor(v, o));
    return v;
}

__device__ __forceinline__ void p0_transpose_item(const float* W, int K, int N, bf16* WT, int k0, int n0, int drow0, LAS float* scr, int lane) {
#pragma unroll 8
    for (int i = 0; i < 32; ++i) { const int kk = 2 * i + (lane >> 5); scr[kk * 33 + (lane & 31)] = W[(size_t)(k0 + kk) * N + n0 + (lane & 31)]; }
    LDS_WAIT(); asm volatile("" ::: "memory");
    const int c = lane & 7;
#pragma unroll
    for (int j = 0; j < 4; ++j) { const int n = (lane >> 3) + 8 * j; const LAS float* s = scr + (8 * c) * 33 + n;
        v4u o; o.x = pk2(s[0 * 33], s[1 * 33]); o.y = pk2(s[2 * 33], s[3 * 33]); o.z = pk2(s[4 * 33], s[5 * 33]); o.w = pk2(s[6 * 33], s[7 * 33]);
        *(GAS v4u*)(WT + (size_t)(drow0 + n) * K + k0 + 8 * c) = o; }
    LDS_WAIT(); asm volatile("" ::: "memory");
}

__device__ __forceinline__ void norm_row(const float* src, const float* g, bf16* hout, int lane) {
    const GAS f32x4* xr = (const GAS f32x4*)src + lane; const GAS f32x4* gr = (const GAS f32x4*)g + lane;
    f32x4 v[8]; float ss = 0.f;
#pragma unroll
    for (int j = 0; j < 8; ++j) { v[j] = xr[64 * j]; ss += (v[j].x * v[j].x + v[j].y * v[j].y) + (v[j].z * v[j].z + v[j].w * v[j].w); }
    const float r = 1.0f / sqrtf(wave_sum(ss) * (1.0f / DM) + RMS_EPS);
    GAS v2u* o8 = (GAS v2u*)hout + lane;
#pragma unroll
    for (int j = 0; j < 8; ++j) { const f32x4 gg = gr[64 * j]; v2u o; o.x = pk2(v[j].x * r * gg.x, v[j].y * r * gg.y); o.y = pk2(v[j].z * r * gg.z, v[j].w * r * gg.w); o8[64 * j] = o; }
}
__device__ __forceinline__ void thin_row(const float* xsrc, const float* f, const float* gpost, float coef, const float* gpre, float* xout, bf16* hout, int lane) {
    const GAS f32x4* xr = (const GAS f32x4*)xsrc + lane; const GAS f32x4* fr = (const GAS f32x4*)f + lane; const GAS f32x4* gp = (const GAS f32x4*)gpost + lane;
    f32x4 xv[8], fv[8]; float ss = 0.f;
#pragma unroll
    for (int j = 0; j < 8; ++j) { fv[j] = fr[64 * j]; xv[j] = xr[64 * j]; ss += (fv[j].x * fv[j].x + fv[j].y * fv[j].y) + (fv[j].z * fv[j].z + fv[j].w * fv[j].w); }
    const float r = coef / sqrtf(wave_sum(ss) * (1.0f / DM) + RMS_EPS);
    GAS f32x4* xo = (GAS f32x4*)xout + lane; float s2 = 0.f;
#pragma unroll
    for (int j = 0; j < 8; ++j) { const f32x4 gg = gp[64 * j]; xv[j] = xv[j] + fv[j] * r * gg; xo[64 * j] = xv[j]; s2 += (xv[j].x * xv[j].x + xv[j].y * xv[j].y) + (xv[j].z * xv[j].z + xv[j].w * xv[j].w); }
    if (gpre) {
        const float r2 = 1.0f / sqrtf(wave_sum(s2) * (1.0f / DM) + RMS_EPS);
        const GAS f32x4* gq = (const GAS f32x4*)gpre + lane; GAS v2u* o8 = (GAS v2u*)hout + lane;
#pragma unroll
        for (int j = 0; j < 8; ++j) { const f32x4 gg = gq[64 * j]; v2u o; o.x = pk2(xv[j].x * r2 * gg.x, xv[j].y * r2 * gg.y); o.y = pk2(xv[j].z * r2 * gg.z, xv[j].w * r2 * gg.w); o8[64 * j] = o; }
    }
}

__device__ __forceinline__ void naive_attend(const bf16* P, LAS float* qs, LAS float* sc, LAS int* tb, int nseg, int lane, float& o0, float& o1, float& lse) {
    WAVE_SYNC();
    int total = 0;
    for (int sg = 0; sg < nseg; ++sg) {
        const int koff = tb[sg * 8 + 0], stride = tb[sg * 8 + 2], cnt = tb[sg * 8 + 3]; const float b0 = __int_as_float(tb[sg * 8 + 4]), bs = __int_as_float(tb[sg * 8 + 5]);
        for (int j = lane; j < cnt; j += 64) {
            const GAS v4u* kr = (const GAS v4u*)(P + ((long)koff + (long)j * stride));
            float a = 0.f;
#pragma unroll 4
            for (int c = 0; c < 16; ++c) { const v4u w = kr[c]; const LAS f32x4* q4 = (const LAS f32x4*)(qs + 8 * c); const f32x4 qa = q4[0], qb = q4[1];
                a += qa.x * bf_lo(w.x) + qa.y * bf_hi(w.x) + qa.z * bf_lo(w.y) + qa.w * bf_hi(w.y) + qb.x * bf_lo(w.z) + qb.y * bf_hi(w.z) + qb.z * bf_lo(w.w) + qb.w * bf_hi(w.w); }
            sc[total + j] = a - (b0 + bs * (float)j);
        }
        total += cnt;
    }
    WAVE_SYNC();
    float m = -INFINITY;
    for (int j = lane; j < total; j += 64) m = fmaxf(m, sc[j]);
    m = wave_max(m);
    float l = 0.f;
    for (int j = lane; j < total; j += 64) { const float p = __expf(sc[j] - m); sc[j] = p; l += p; }
    l = wave_sum(l);
    WAVE_SYNC();
    float a0 = 0.f, a1 = 0.f; int base = 0;
    for (int sg = 0; sg < nseg; ++sg) {
        const int voff = tb[sg * 8 + 1], stride = tb[sg * 8 + 2], cnt = tb[sg * 8 + 3];
        const GAS unsigned* vp = (const GAS unsigned*)(P + (long)voff) + lane;
#pragma unroll 4
        for (int j = 0; j < cnt; ++j) { const float p = sc[base + j]; const unsigned w = vp[((long)j * stride) / 2]; a0 += p * bf_lo(w); a1 += p * bf_hi(w); }
        base += cnt;
    }
    const float rl = 1.0f / l; o0 = a0 * rl; o1 = a1 * rl; lse = m + __logf(l);
    WAVE_SYNC();
}
__device__ __forceinline__ void tb_set(LAS int* tb, int sg, int koff, int voff, int stride, int cnt, float b0, float bs) {
    tb[sg * 8 + 0] = koff; tb[sg * 8 + 1] = voff; tb[sg * 8 + 2] = stride; tb[sg * 8 + 3] = cnt; tb[sg * 8 + 4] = __float_as_int(b0); tb[sg * 8 + 5] = __float_as_int(bs);
}
__device__ __forceinline__ void load_q(const bf16* qrow, LAS float* qs, int lane) {
    const unsigned w = *((const GAS unsigned*)qrow + lane); qs[2 * lane] = bf_lo(w) * SCALE; qs[2 * lane + 1] = bf_hi(w) * SCALE;
}
__device__ __forceinline__ float slope_of(int h) { return exp2f(-8.0f * (float)(h + 1) / (float)NH); }

struct Args { const float* in[10]; float* out; unsigned char* ws; };
__global__ void __launch_bounds__(NWAVES * 64, 2) trunk_fwd(Args args) {
    extern __shared__ __attribute__((aligned(16))) unsigned char lds_raw[];
    Ctx F;
    F.lds = (LAS unsigned char*)lds_raw;
    volatile LAS unsigned* MISC = (volatile LAS unsigned*)(F.lds + MISC_OFF);
    F.tid = threadIdx.x; F.lane = F.tid & 63; F.wave = __builtin_amdgcn_readfirstlane(F.tid >> 6);
    F.G = gridDim.x; { const int bx = blockIdx.x; F.vcu = (F.G % 8 == 0) ? (bx % 8) * (F.G / 8) + bx / 8 : bx; }
    unsigned char* ws = args.ws;
    unsigned* ctl = (unsigned*)(ws + WS_CTL);
    for (int u = F.tid; u < (LDS_BYTES - LDSCTL_OFF) / 4; u += NWAVES * 64) ((LAS unsigned*)(F.lds + LDSCTL_OFF))[u] = 0u;
    __syncthreads();
    XcdBarrier bar = xcd_barrier_post(ctl + CW_BAR, MISC + 8);
#define GRID_BAR() xcd_barrier(bar)

    const float* x_in = args.in[0]; const float* mem = args.in[1]; const float* g_pre = args.in[2]; const float* g_post = args.in[3]; const float* g_mem = args.in[4];
    const float* w_ffn_in = args.in[5]; const float* w_ffn_out = args.in[6]; const float* w_in = args.in[7]; const float* w_mem_kv = args.in[8]; const float* w_out = args.in[9];
    float* X = args.out;
    bf16* Hb = (bf16*)(ws + WS_H); bf16* Ab = (bf16*)(ws + WS_A); float* Fb = (float*)(ws + WS_F); bf16* Pb = (bf16*)(ws + WS_P); bf16* Cat = (bf16*)(ws + WS_CAT);
    float* kmean = (float*)(ws + WS_KMEAN);
#define PHASE_BEGIN() int tid_ = threadIdx.x; asm volatile("" : "+v"(tid_)); int bx_ = blockIdx.x, G_ = gridDim.x; asm volatile("" : "+s"(bx_), "+s"(G_)); \
    const int lane = tid_ & 63, wave = __builtin_amdgcn_readfirstlane(tid_ >> 6), vcu = (G_ % 8 == 0) ? (bx_ % 8) * (G_ / 8) + bx_ / 8 : bx_, gw = vcu * NWAVES + wave, NGW = G_ * NWAVES; (void)lane; (void)gw; (void)NGW

    {
        PHASE_BEGIN();
        LAS float* scr = (LAS float*)(F.lds + RING_OFF + wave * 16384);
        constexpr int I_IN = (DM / 64) * (2 * DFF / 32), I_OUT = (DFF / 64) * (DM / 32), I_QKV = (DM / 64) * (IN_W / 32), I_MKV = (DM / 64) * (KVW / 32), I_O = (DM / 64) * (DM / 32);
        constexpr int I_LAYER = 2 * I_IN + 2 * I_OUT + I_QKV + I_MKV + I_O;
        for (int it = gw; it < DEPTH * I_LAYER; it += NGW) {
            const int l = it / I_LAYER; int r = it % I_LAYER;
            unsigned char* wl = ws + WS_W + (size_t)l * LW;
            if (r < 2 * I_IN) { const int half = r / I_IN; r %= I_IN; const int nblk = 2 * DFF / 32, k0 = 64 * (r / nblk), n0 = 32 * (r % nblk);
                const int j = n0 < DFF ? n0 : n0 - DFF; const int drow = 256 * (j / 128) + (n0 < DFF ? 0 : 128) + (j % 128);
                p0_transpose_item(w_ffn_in + (size_t)(l * 2 + half) * DM * 2 * DFF, DM, 2 * DFF, (bf16*)(wl + LW_IN + (size_t)half * 44 * MiB), k0, n0, drow, scr, lane); continue; }
            r -= 2 * I_IN;
            if (r < 2 * I_OUT) { const int half = r / I_OUT; r %= I_OUT; const int nblk = DM / 32, k0 = 64 * (r / nblk), n0 = 32 * (r % nblk);
                p0_transpose_item(w_ffn_out + (size_t)(l * 2 + half) * DFF * DM, DFF, DM, (bf16*)(wl + LW_OUT + (size_t)half * 22 * MiB), k0, n0, n0, scr, lane); continue; }
            r -= 2 * I_OUT;
            if (r < I_QKV) { const int nblk = IN_W / 32, k0 = 64 * (r / nblk), n0 = 32 * (r % nblk);
                p0_transpose_item(w_in + (size_t)l * DM * IN_W, DM, IN_W, (bf16*)(wl + LW_QKV), k0, n0, n0, scr, lane); continue; }
            r -= I_QKV;
            if (r < I_MKV) { const int nblk = KVW / 32, k0 = 64 * (r / nblk), n0 = 32 * (r % nblk);
                p0_transpose_item(w_mem_kv + (size_t)l * DM * KVW, DM, KVW, (bf16*)(wl + LW_QKV), k0, n0, IN_W + n0, scr, lane); continue; }
            r -= I_MKV;
            { const int nblk = DM / 32, k0 = 64 * (r / nblk), n0 = 32 * (r % nblk);
                p0_transpose_item(w_out + (size_t)l * DM * DM, DM, DM, (bf16*)(wl + LW_O), k0, n0, n0, scr, lane); }
        }
        for (int m = gw; m < SEQ; m += NGW) norm_row(x_in + (size_t)m * DM, g_pre, Hb + (size_t)m * DM, lane);
    }
    GRID_BAR();

#ifndef DBG_MAXSUB
#define DBG_MAXSUB (3 * DEPTH)
#endif
    for (int sub = 0; sub < DBG_MAXSUB; ++sub) {
        const int l = sub / 3, part = sub % 3;
        unsigned char* wl = ws + WS_W + (size_t)l * LW;
        if (part != 1) {
            const int half = part >> 1;
            {
                int cc = blockIdx.x, GG = gridDim.x; asm volatile("" : "+s"(cc), "+s"(GG));
                pg8::Gemm g{Hb, (const bf16*)(wl + LW_IN + (size_t)half * 44 * MiB), SEQ, 2 * DFF, DM}; pg8::XOrder S; S.init(SEQ, 2 * DFF, GG, cc, 0);
                pg8::EpiSwiGLU E{Ab, DFF};
                pg8::gemm_phase<pg8::EpiSwiGLU, pg8::XOrder, true, true>(F.lds + RING_OFF, g, S, E);
            }
            GRID_BAR();
            {
                int cc = blockIdx.x, GG = gridDim.x; asm volatile("" : "+s"(cc), "+s"(GG));
                pg8::Gemm g{Ab, (const bf16*)(wl + LW_OUT + (size_t)half * 22 * MiB), SEQ, DM, DFF}; pg8::XOrder S; S.init(SEQ, DM, GG, cc, 0);
                pg8::EpiF32 E{Fb, DM};
                pg8::gemm_phase<pg8::EpiF32, pg8::XOrder, true, true>(F.lds + RING_OFF, g, S, E);
            }
            GRID_BAR();
        } else {
            {
                int cc = blockIdx.x, GG = gridDim.x; asm volatile("" : "+s"(cc), "+s"(GG));
                pg8::Gemm g{Hb, (const bf16*)(wl + LW_QKV), SEQ, IN_W, DM}; pg8::XOrder S; S.init(SEQ, IN_W, GG, cc, KVW / 256);
                pg8::EpiBf16 E{Pb, LDP};
                pg8::gemm_phase<pg8::EpiBf16, pg8::XOrder, true, true>(F.lds + RING_OFF, g, S, E);
            }
            GRID_BAR();
#define ATTN_SCRATCH() LAS float* qs = (LAS float*)(F.lds + RING_OFF + wave * 8192); LAS float* sc = qs + 128; LAS int* tb = (LAS int*)(qs + 128 + 1024 + 64)
            if ((l & 1) == 0) {
                { PHASE_BEGIN();
                for (int it = gw; it < NH * MOBA_NB; it += NGW) { const int h = it / MOBA_NB, n = it % MOBA_NB;
                    const GAS unsigned* kp = (const GAS unsigned*)(Pb + (size_t)(n * MOBA_BLK) * LDP + KCOL + h * HD) + lane; float a0 = 0.f, a1 = 0.f;
#pragma unroll 8
                    for (int r = 0; r < MOBA_BLK; ++r) { const unsigned w = kp[(size_t)r * (LDP / 2)]; a0 += bf_lo(w); a1 += bf_hi(w); }
                    kmean[(size_t)it * HD + 2 * lane] = a0 * (1.0f / MOBA_BLK); kmean[(size_t)it * HD + 2 * lane + 1] = a1 * (1.0f / MOBA_BLK); }
                }
                GRID_BAR();
                { PHASE_BEGIN(); ATTN_SCRATCH();
                for (int it = gw; it < NH * SEQ; it += NGW) { const int h = it / SEQ, s = it % SEQ, qb = s >> 8; const float slope = slope_of(h);
                    load_q(Pb + (size_t)s * LDP + QCOL + h * HD, qs, lane); WAVE_SYNC();
                    float g = -INFINITY;
                    if (lane < MOBA_NB) { g = -1e30f; if (lane < qb) { const float* km = kmean + (size_t)(h * MOBA_NB + lane) * HD; float a = 0.f; for (int d = 0; d < HD; ++d) a += qs[d] * km[d]; g = a; } }
                    int nseg = 0;
                    for (int r = 0; r < 3; ++r) { const float m = wave_max(g); if (!(m > -1e29f)) break;
                        const unsigned long long b = __ballot(g == m); const int n = __ffsll((long long)b) - 1; if (lane == n) g = -INFINITY;
                        if (lane == 0) tb_set(tb, nseg, (n * MOBA_BLK) * LDP + KCOL + h * HD, (n * MOBA_BLK) * LDP + VCOL + h * HD, LDP, MOBA_BLK, slope * (float)(s - n * MOBA_BLK), -slope);
                        ++nseg; }
                    if (lane == 0) tb_set(tb, nseg, (qb * MOBA_BLK) * LDP + KCOL + h * HD, (qb * MOBA_BLK) * LDP + VCOL + h * HD, LDP, (s & (MOBA_BLK - 1)) + 1, slope * (float)(s - qb * MOBA_BLK), -slope);
                    ++nseg;
                    float o0, o1, lse; naive_attend(Pb, qs, sc, tb, nseg, lane, o0, o1, lse);
                    *((GAS unsigned*)(Cat + (size_t)s * DM + h * HD) + lane) = pk2(o0, o1); }
                }
            } else {
                PHASE_BEGIN(); ATTN_SCRATCH();
                for (int it = gw; it < 4 * SEQ; it += NGW) { const int jh = it / SEQ, s = it % SEQ;
                    float o0[3], o1[3], ls[3];
#pragma unroll
                    for (int gi = 0; gi < 3; ++gi) { const int h = 4 * gi + jh, d = gi == 0 ? 1 : (gi == 1 ? 4 : 16); const float slope = slope_of(h);
                        load_q(Pb + (size_t)s * LDP + QCOL + h * HD, qs, lane);
                        int cnt = s / d; cnt = (cnt < 128 ? cnt : 128) + 1;
                        if (lane == 0) tb_set(tb, 0, s * LDP + KCOL + h * HD, s * LDP + VCOL + h * HD, -d * LDP, cnt, 0.f, slope * (float)d);
                        naive_attend(Pb, qs, sc, tb, 1, lane, o0[gi], o1[gi], ls[gi]); }
                    const float mx = fmaxf(ls[0], fmaxf(ls[1], ls[2])); const float e0 = __expf(ls[0] - mx), e1 = __expf(ls[1] - mx), e2 = __expf(ls[2] - mx); const float ri = 1.0f / (e0 + e1 + e2);
                    *((GAS unsigned*)(Cat + (size_t)s * DM + (0 + jh) * HD) + lane) = pk2(o0[0] * e0 * ri, o1[0] * e0 * ri);
                    *((GAS unsigned*)(Cat + (size_t)s * DM + (4 + jh) * HD) + lane) = pk2(o0[1] * e1 * ri, o1[1] * e1 * ri);
                    *((GAS unsigned*)(Cat + (size_t)s * DM + (8 + jh) * HD) + lane) = pk2(o0[2] * e2 * ri, o1[2] * e2 * ri); }
            }
            { PHASE_BEGIN(); ATTN_SCRATCH();
            for (int it = gw; it < NMH * SEQ; it += NGW) { const int hm = it / SEQ, s = it % SEQ;
                load_q(Pb + (size_t)s * LDP + QMCOL + hm * HD, qs, lane);
                if (lane == 0) tb_set(tb, 0, SEQ * LDP + KMCOL + hm * HD, SEQ * LDP + VMCOL + hm * HD, LDP, NMEM, 0.f, 0.f);
                float o0, o1, lse; naive_attend(Pb, qs, sc, tb, 1, lane, o0, o1, lse);
                *((GAS unsigned*)(Cat + (size_t)s * DM + SELF_W + hm * HD) + lane) = pk2(o0, o1); }
            }
            GRID_BAR();
            {
                int cc = blockIdx.x, GG = gridDim.x; asm volatile("" : "+s"(cc), "+s"(GG));
                pg8::Gemm g{Cat, (const bf16*)(wl + LW_O), SEQ, DM, DM}; pg8::XOrder S; S.init(SEQ, DM, GG, cc, 0);
                pg8::EpiF32 E{Fb, DM};
                pg8::gemm_phase<pg8::EpiF32, pg8::XOrder, true, true>(F.lds + RING_OFF, g, S, E);
            }
            GRID_BAR();
        }
        {
            PHASE_BEGIN();
            const float* xsrc = sub == 0 ? x_in : X;
            const float* gpo = g_post + (size_t)(l * 3 + part) * DM;
            const float* gpr = (sub + 1 < 3 * DEPTH) ? g_pre + (size_t)(sub + 1) * DM : nullptr;
            const float coef = part == 1 ? 1.0f : 0.5f;
            const int nrows = part == 0 ? MROWS : SEQ;
            for (int m = gw; m < nrows; m += NGW) {
                if (m < SEQ) thin_row(xsrc + (size_t)m * DM, Fb + (size_t)m * DM, gpo, coef, gpr, X + (size_t)m * DM, Hb + (size_t)m * DM, lane);
                else norm_row(mem + (size_t)(m - SEQ) * DM, g_mem + (size_t)l * DM, Hb + (size_t)m * DM, lane);
            }
        }
        if (sub + 1 < 3 * DEPTH) GRID_BAR();
    }
}

extern "C" void kernel_launch(void* const* d_in, const int* in_sizes, int n_in, void* d_out, int out_size, void* d_ws, size_t ws_size, hipStream_t stream) {
    static int grid = 0;
    if (grid == 0) {
        if (n_in != 10 || in_sizes[0] != SEQ * DM || out_size != SEQ * DM || ws_size < WS_END) { fprintf(stderr, "kernel_launch: shape mismatch: n_in %d in0 %d out %d ws %zu (need %zu)\n", n_in, n_in > 0 ? in_sizes[0] : -1, out_size, ws_size, (size_t)WS_END); grid = -1; return; }
        int dev = 0, cus = 0, per_cu = 0;
        if (hipGetDevice(&dev) != hipSuccess || hipDeviceGetAttribute(&cus, hipDeviceAttributeMultiprocessorCount, dev) != hipSuccess) { fprintf(stderr, "kernel_launch: device query failed\n"); grid = -1; return; }
        if (hipFuncSetAttribute((const void*)trunk_fwd, hipFuncAttributeMaxDynamicSharedMemorySize, LDS_BYTES) != hipSuccess) { fprintf(stderr, "kernel_launch: hipFuncSetAttribute failed\n"); grid = -1; return; }
        if (hipOccupancyMaxActiveBlocksPerMultiprocessor(&per_cu, (const void*)trunk_fwd, NWAVES * 64, LDS_BYTES) != hipSuccess || per_cu < 1)
            fprintf(stderr, "kernel_launch: note: occupancy query reports %d workgroups per CU\n", per_cu);
        (void)hipGetLastError();
        grid = cus;
    }
    if (grid < 0) return;
    if (hipMemsetAsync((char*)d_ws + WS_CTL, 0, CTL_ZERO_BYTES, stream) != hipSuccess) { fprintf(stderr, "kernel_launch: memset failed\n"); return; }
    Args a{};
    for (int i = 0; i < 10; ++i) a.in[i] = (const float*)d_in[i];
    a.out = (float*)d_out; a.ws = (unsigned char*)d_ws;
    hipLaunchKernelGGL(trunk_fwd, dim3(grid), dim3(NWAVES * 64), LDS_BYTES, stream, a);
    const hipError_t le = hipPeekAtLastError();
    if (le != hipSuccess) fprintf(stderr, "kernel_launch: launch failed: %s\n", hipGetErrorName(le));
}
```

```cpp
#include <hip/hip_runtime.h>
#include <cstdio>
#include <cstdint>
#include <cmath>
#define FUSE_THIN 0
namespace pg8 {
#define PG8_LAS __attribute__((address_space(3)))
typedef unsigned short bf16_t;
typedef short bf16x8 __attribute__((ext_vector_type(8)));
typedef float f32x4 __attribute__((ext_vector_type(4)));
typedef unsigned u32x4 __attribute__((ext_vector_type(4)));
typedef int i32x4 __attribute__((ext_vector_type(4)));
constexpr int BM = 256, BK = 64, HALF = 128, HTB = HALF * BK * 2  , STAGE_BYTES = 8 * HTB, NXCD = 8, WGM = 8;

__host__ __device__ __forceinline__ int lds_byte(int r, int c) { const int st = (r >> 4) * 2 + (c >> 5), rr = r & 15, cc = c & 31, ob = rr * 64 + cc * 2; return st * 1024 + (ob ^ (((ob >> 9) & 1) << 5)); }
__host__ __device__ __forceinline__ void stage_rc(int b, int& R, int& C) { const int st = b / 1024, sb = b % 1024, swz = sb ^ (((sb >> 9) & 1) << 5); R = (st >> 1) * 16 + swz / 64; C = (st & 1) * 32 + (swz % 64) / 2; }
__host__ __device__ __forceinline__ int perm32(int rho) { const int n = rho >> 4, i = rho & 15; return 8 * (i >> 2) + 4 * n + (i & 3); }

struct Unit { int pm, pn; };
struct Gemm { const bf16_t* A; const bf16_t* Bt; int M, N, K; };

struct StaticOrder {
    int nM, nN, nwg, G, c;
    __host__ __device__ void init(int M, int N, int G_, int c_) { nM = M / BM; nN = N / BM; nwg = nM * nN; G = G_; c = c_; }
    __host__ __device__ bool next(int i, Unit& u) const {
        const long L = (long)i * G + c; if (L >= nwg) return false;
        int wgid = (int)L; { const int q = nwg / NXCD, r = nwg % NXCD, xcd = wgid % NXCD, off = wgid / NXCD; wgid = (xcd < r ? xcd * (q + 1) : r * (q + 1) + (xcd - r) * q) + off; }
        const int nig = WGM * nN, gid = wgid / nig, fm = gid * WGM, gsz = (nM - fm) < WGM ? (nM - fm) : WGM;
        u.pm = fm + ((wgid % nig) % gsz); u.pn = (wgid % nig) / gsz; return true;
    }
    __device__ __forceinline__ void a_ready(const Unit&) const {}
    __device__ __forceinline__ void done(const Unit&) const {}
};

__device__ __forceinline__ unsigned cvt_pk_bf16(float lo, float hi) { unsigned r; asm volatile("v_cvt_pk_bf16_f32 %0, %1, %2" : "=v"(r) : "v"(lo), "v"(hi)); return r; }
typedef float f32x2 __attribute__((ext_vector_type(2)));
struct XOrder {
    int nM, nN, nwg, G, c, extra;
    __host__ __device__ void init(int M, int N, int G_, int c_, int extra_) { nM = M / BM; nN = N / BM; nwg = nM * nN; G = G_; c = c_; extra = extra_; }
    __host__ __device__ bool next(int i, Unit& u) const {
        const long L = (long)i * G + c;
        if (L >= nwg) { const long e = L - nwg; if (e >= extra) return false; u.pm = nM; u.pn = nN + (int)e; return true; }
        int wgid = (int)L; { const int q = nwg / NXCD, r = nwg % NXCD, xcd = wgid % NXCD, off = wgid / NXCD; wgid = (xcd < r ? xcd * (q + 1) : r * (q + 1) + (xcd - r) * q) + off; }
        const int nig = WGM * nN, gid = wgid / nig, fm = gid * WGM, gsz = (nM - fm) < WGM ? (nM - fm) : WGM;
        u.pm = fm + ((wgid % nig) % gsz); u.pn = (wgid % nig) / gsz; return true;
    }
    __device__ __forceinline__ void a_ready(const Unit&) const {}
    __device__ __forceinline__ void done(const Unit&) const {}
};

struct NoPre {};
struct RowPre { int buf; };
struct EpiF32 {
    static constexpr bool PERM = false, AFTER_DRAIN = false;
    typedef NoPre Pre;
    float* C; int ldc;
    __device__ __forceinline__ void preload(Pre&, const Unit&, int, int, int) const {}
    __device__ __forceinline__ void operator()(const f32x4 (&acc)[2][2][4][2], const Unit& u, int wr, int wc, int fr, int fq, const Pre&) const {
        const int row0 = u.pm * BM + wr * 64 + fr, col0 = u.pn * BM + wc * 32 + 4 * fq;
#pragma unroll
        for (int ai = 0; ai < 2; ++ai)
#pragma unroll
            for (int m = 0; m < 4; ++m) { float* rowp = C + (size_t)(row0 + ai * HALF + m * 16) * ldc + col0;
#pragma unroll
                for (int bj = 0; bj < 2; ++bj)
#pragma unroll
                    for (int n = 0; n < 2; ++n) *(f32x4*)(rowp + bj * HALF + n * 16) = acc[ai][bj][m][n]; }
    }
};
struct EpiBf16 {
    static constexpr bool PERM = true, AFTER_DRAIN = false;
    typedef RowPre Pre;
    bf16_t* O; int ldc; const float* rs; PG8_LAS float* tab;
    __device__ __forceinline__ void preload(Pre& p, const Unit& u, int wid, int lane, int ui) const {
        p.buf = ui & 1;
        if (rs && wid < 4) __builtin_amdgcn_global_load_lds((const unsigned*)(rs + u.pm * BM + wid * 64 + lane), (PG8_LAS unsigned*)(tab + p.buf * 256 + wid * 64), 4, 0, 0);
    }
    __device__ __forceinline__ void operator()(const f32x4 (&acc)[2][2][4][2], const Unit& u, int wr, int wc, int fr, int fq, const Pre& p) const {
        const int row0 = u.pm * BM + wr * 64 + fr, col0 = u.pn * BM + wc * 32 + 8 * fq;
#pragma unroll
        for (int ai = 0; ai < 2; ++ai)
#pragma unroll
            for (int m = 0; m < 4; ++m) { bf16_t* rowp = O + (size_t)(row0 + ai * HALF + m * 16) * ldc + col0; const float s = rs ? tab[p.buf * 256 + wr * 64 + fr + ai * HALF + m * 16] : 1.0f;
#pragma unroll
                for (int bj = 0; bj < 2; ++bj) { const f32x4 v0 = acc[ai][bj][m][0] * s, v1 = acc[ai][bj][m][1] * s;
                    u32x4 w; w.x = cvt_pk_bf16(v0[0], v0[1]); w.y = cvt_pk_bf16(v0[2], v0[3]); w.z = cvt_pk_bf16(v1[0], v1[1]); w.w = cvt_pk_bf16(v1[2], v1[3]);
                    *(u32x4*)(rowp + bj * HALF) = w; } }
    }
};

__device__ __forceinline__ float bfl(unsigned w) { return __uint_as_float(w << 16); }
__device__ __forceinline__ float bfh(unsigned w) { return __uint_as_float(w & 0xffff0000u); }
struct EpiNormRes {
    static constexpr bool PERM = true, AFTER_DRAIN = true;
    typedef NoPre Pre;
    bf16_t* X; const float* gpost; float coef; float* xout; float* rstd; unsigned* slot1; unsigned* slot2; unsigned* cnt1; unsigned* cnt2; unsigned want; unsigned* tmo; int ldx; float inv_n, eps;
    __device__ __forceinline__ void preload(Pre&, const Unit&, int, int, int) const {}
    __device__ __forceinline__ void fused(f32x4 (&acc)[2][2][4][2], const Unit& u, int wr, int wc, int fr, int fq, PG8_LAS unsigned char* lds, int wid, int lane) const {
        PG8_LAS float* P = (PG8_LAS float*)lds; PG8_LAS float* S = P + 1024; PG8_LAS unsigned* flag = (PG8_LAS unsigned*)(S + 256);
        const int tid = wid * 64 + lane, rbase = u.pm * BM + wr * 64 + fr, cbase = u.pn * BM + wc * 32 + 8 * fq;
        u32x4 xv[4][2]; f32x4 gv[2][2];
#pragma unroll
        for (int m = 0; m < 4; ++m)
#pragma unroll
            for (int bj = 0; bj < 2; ++bj) xv[m][bj] = *(const u32x4*)(X + (size_t)(rbase + m * 16) * ldx + cbase + bj * HALF);
#pragma unroll
        for (int bj = 0; bj < 2; ++bj) { gv[bj][0] = *(const f32x4*)(gpost + cbase + bj * HALF); gv[bj][1] = *(const f32x4*)(gpost + cbase + bj * HALF + 4); }
#pragma unroll
        for (int ai = 0; ai < 2; ++ai)
#pragma unroll
            for (int m = 0; m < 4; ++m) { float s = 0.f;
#pragma unroll
                for (int bj = 0; bj < 2; ++bj)
#pragma unroll
                    for (int n = 0; n < 2; ++n) { const f32x4 x = acc[ai][bj][m][n]; s += (x[0] * x[0] + x[1] * x[1]) + (x[2] * x[2] + x[3] * x[3]); }
                s += __shfl_xor(s, 16); s += __shfl_xor(s, 32);
                if (fq == 0) P[(ai * HALF + wr * 64 + m * 16 + fr) * 4 + wc] = s; }
        asm volatile("s_waitcnt lgkmcnt(0)" ::: "memory"); __builtin_amdgcn_s_barrier(); asm volatile("" ::: "memory");
        if (tid < 256) { const f32x4 p = *(const PG8_LAS f32x4*)(P + tid * 4); const float tot = (p[0] + p[1]) + (p[2] + p[3]);
            __hip_atomic_store(slot1 + (size_t)(u.pm * BM + tid) * 8 + u.pn, __float_as_uint(tot), __ATOMIC_RELAXED, __HIP_MEMORY_SCOPE_AGENT); }
        asm volatile("s_waitcnt vmcnt(0)" ::: "memory");
        if (wid < 4 && lane == 0) __hip_atomic_fetch_add(cnt1 + 64 * u.pm, 1u, __ATOMIC_RELAXED, __HIP_MEMORY_SCOPE_AGENT);
        if (wid == 0) {
            const unsigned long long t0 = __builtin_amdgcn_s_memrealtime();
            for (;;) {
                if ((unsigned)__builtin_amdgcn_readfirstlane(__hip_atomic_load(cnt1 + 64 * u.pm, __ATOMIC_RELAXED, __HIP_MEMORY_SCOPE_AGENT)) >= want) break;
                if (__builtin_amdgcn_s_memrealtime() - t0 > 2000000ull) { if (lane == 0) __hip_atomic_store(tmo, 1u, __ATOMIC_RELAXED, __HIP_MEMORY_SCOPE_AGENT); break; }
                __builtin_amdgcn_s_sleep(2);
            }
            __builtin_amdgcn_fence(__ATOMIC_ACQUIRE, "agent");
            if (lane == 0) flag[0] = 1u;
        }
        asm volatile("s_waitcnt vmcnt(0) lgkmcnt(0)" ::: "memory"); __builtin_amdgcn_s_barrier(); asm volatile("" ::: "memory");
        if (tid < 256) { const unsigned* sl = slot1 + (size_t)(u.pm * BM + tid) * 8; float sum = 0.f;
#pragma unroll
            for (int t = 0; t < 8; ++t) sum += __uint_as_float(__hip_atomic_load(sl + t, __ATOMIC_RELAXED, __HIP_MEMORY_SCOPE_AGENT));
            S[tid] = coef / sqrtf(sum * inv_n + eps); }
        asm volatile("s_waitcnt lgkmcnt(0)" ::: "memory"); __builtin_amdgcn_s_barrier(); asm volatile("" ::: "memory");
        u32x4 xw[4][2];
#define NR_ROWGROUP(ai, m, XV) do { const int rl = (ai) * HALF + wr * 64 + (m) * 16 + fr; const float r = S[rl]; float s2 = 0.f; \
            _Pragma("unroll") for (int bj = 0; bj < 2; ++bj) { const f32x4 a0 = acc[ai][bj][m][0], a1 = acc[ai][bj][m][1], g0 = gv[bj][0], g1 = gv[bj][1]; const u32x4 x = XV[m][bj]; \
                const float y0 = bfl(x.x) + a0[0] * r * g0[0], y1 = bfh(x.x) + a0[1] * r * g0[1], y2 = bfl(x.y) + a0[2] * r * g0[2], y3 = bfh(x.y) + a0[3] * r * g0[3]; \
                const float y4 = bfl(x.z) + a1[0] * r * g1[0], y5 = bfh(x.z) + a1[1] * r * g1[1], y6 = bfl(x.w) + a1[2] * r * g1[2], y7 = bfh(x.w) + a1[3] * r * g1[3]; \
                s2 += (y0 * y0 + y1 * y1) + (y2 * y2 + y3 * y3) + (y4 * y4 + y5 * y5) + (y6 * y6 + y7 * y7); \
                u32x4 w; w.x = cvt_pk_bf16(y0, y1); w.y = cvt_pk_bf16(y2, y3); w.z = cvt_pk_bf16(y4, y5); w.w = cvt_pk_bf16(y6, y7); \
                const size_t off = (size_t)(rbase + (ai) * HALF + (m) * 16) * ldx + cbase + bj * HALF; \
                *(u32x4*)(X + off) = w; \
                if (xout) { *(f32x4*)(xout + off) = (f32x4){y0, y1, y2, y3}; *(f32x4*)(xout + off + 4) = (f32x4){y4, y5, y6, y7}; } } \
            s2 += __shfl_xor(s2, 16); s2 += __shfl_xor(s2, 32); \
            if (fq == 0) P[rl * 4 + wc] = s2; } while (0)
#define NR_LOADW(m) do { _Pragma("unroll") for (int bj = 0; bj < 2; ++bj) xw[m][bj] = *(const u32x4*)(X + (size_t)(rbase + HALF + (m) * 16) * ldx + cbase + bj * HALF); } while (0)
        NR_LOADW(0); NR_LOADW(1); asm volatile("" ::: "memory");
        NR_ROWGROUP(0, 0, xv); NR_ROWGROUP(0, 1, xv); asm volatile("" ::: "memory");
        NR_LOADW(2); NR_LOADW(3); asm volatile("" ::: "memory");
        NR_ROWGROUP(0, 2, xv); NR_ROWGROUP(0, 3, xv); asm volatile("" ::: "memory");
        NR_ROWGROUP(1, 0, xw); NR_ROWGROUP(1, 1, xw); NR_ROWGROUP(1, 2, xw); NR_ROWGROUP(1, 3, xw);
#undef NR_ROWGROUP
#undef NR_LOADW
        asm volatile("s_waitcnt lgkmcnt(0)" ::: "memory"); __builtin_amdgcn_s_barrier(); asm volatile("" ::: "memory");
        if (tid < 256) { const f32x4 p = *(const PG8_LAS f32x4*)(P + tid * 4); const float tot = (p[0] + p[1]) + (p[2] + p[3]);
            __hip_atomic_store(slot2 + (size_t)(u.pm * BM + tid) * 8 + u.pn, __float_as_uint(tot), __ATOMIC_RELAXED, __HIP_MEMORY_SCOPE_AGENT); }
        asm volatile("s_waitcnt vmcnt(0)" ::: "memory");
        if (wid < 4) { unsigned old = 0u;
            if (lane == 0) old = __hip_atomic_fetch_add(cnt2 + 64 * u.pm, 1u, __ATOMIC_RELAXED, __HIP_MEMORY_SCOPE_AGENT);
            old = (unsigned)__builtin_amdgcn_readfirstlane((int)old);
            if (old + 1u == want) {
                __builtin_amdgcn_fence(__ATOMIC_ACQUIRE, "agent");
                for (int rr = lane; rr < 256; rr += 64) { const unsigned* sl = slot2 + (size_t)(u.pm * BM + rr) * 8; float sum = 0.f;
#pragma unroll
                    for (int t = 0; t < 8; ++t) sum += __uint_as_float(__hip_atomic_load(sl + t, __ATOMIC_RELAXED, __HIP_MEMORY_SCOPE_AGENT));
                    rstd[u.pm * BM + rr] = 1.0f / sqrtf(sum * inv_n + eps); }
            } }
    }
};
__device__ __forceinline__ float silu_mul(float g, float u) { return g * u * __builtin_amdgcn_rcpf(1.0f + __builtin_amdgcn_exp2f(-1.4426950408889634f * g)); }
struct EpiSwiGLU {
    static constexpr bool PERM = true, AFTER_DRAIN = false;
    typedef RowPre Pre;
    bf16_t* O; int ldc; const float* rs; PG8_LAS float* tab;
    __device__ __forceinline__ void preload(Pre& p, const Unit& u, int wid, int lane, int ui) const {
        p.buf = ui & 1;
        if (wid < 4) __builtin_amdgcn_global_load_lds((const unsigned*)(rs + u.pm * BM + wid * 64 + lane), (PG8_LAS unsigned*)(tab + p.buf * 256 + wid * 64), 4, 0, 0);
    }
    __device__ __forceinline__ void operator()(const f32x4 (&acc)[2][2][4][2], const Unit& u, int wr, int wc, int fr, int fq, const Pre& p) const {
        const int row0 = u.pm * BM + wr * 64 + fr, col0 = u.pn * HALF + wc * 32 + 8 * fq;
#pragma unroll
        for (int ai = 0; ai < 2; ++ai)
#pragma unroll
            for (int m = 0; m < 4; ++m) { bf16_t* rowp = O + (size_t)(row0 + ai * HALF + m * 16) * ldc + col0;
                const float s = tab[p.buf * 256 + wr * 64 + fr + ai * HALF + m * 16];
                const f32x4 g0 = acc[ai][0][m][0] * s, g1 = acc[ai][0][m][1] * s, u0 = acc[ai][1][m][0] * s, u1 = acc[ai][1][m][1] * s;
                u32x4 w; w.x = cvt_pk_bf16(silu_mul(g0[0], u0[0]), silu_mul(g0[1], u0[1])); w.y = cvt_pk_bf16(silu_mul(g0[2], u0[2]), silu_mul(g0[3], u0[3]));
                w.z = cvt_pk_bf16(silu_mul(g1[0], u1[0]), silu_mul(g1[1], u1[1])); w.w = cvt_pk_bf16(silu_mul(g1[2], u1[2]), silu_mul(g1[3], u1[3]));
                *(u32x4*)rowp = w; }
    }
};

struct EpiSwiGLU8 {
    static constexpr bool PERM = true, AFTER_DRAIN = false;
    typedef RowPre Pre;
    bf16_t* O; int ldc; const float* rs; const float* cs; PG8_LAS float* tab; PG8_LAS float* ctab;
    __device__ __forceinline__ void preload(Pre& p, const Unit& u, int wid, int lane, int ui) const {
        p.buf = ui & 1;
        if (wid < 4) __builtin_amdgcn_global_load_lds((const unsigned*)(rs + u.pm * BM + wid * 64 + lane), (PG8_LAS unsigned*)(tab + p.buf * 256 + wid * 64), 4, 0, 0);
        else __builtin_amdgcn_global_load_lds((const unsigned*)(cs + u.pn * BM + (wid - 4) * 64 + lane), (PG8_LAS unsigned*)(ctab + p.buf * 256 + (wid - 4) * 64), 4, 0, 0);
    }
    __device__ __forceinline__ void operator()(const f32x4 (&acc)[2][2][4][2], const Unit& u, int wr, int wc, int fr, int fq, const Pre& p) const {
        const int row0 = u.pm * BM + wr * 64 + fr, col0 = u.pn * HALF + wc * 32 + 8 * fq;
        const PG8_LAS float* cg = ctab + p.buf * 256 + wc * 32 + 8 * fq;
        const f32x4 cg0 = *(const PG8_LAS f32x4*)cg, cg1 = *(const PG8_LAS f32x4*)(cg + 4), cu0 = *(const PG8_LAS f32x4*)(cg + HALF), cu1 = *(const PG8_LAS f32x4*)(cg + HALF + 4);
#pragma unroll
        for (int ai = 0; ai < 2; ++ai)
#pragma unroll
            for (int m = 0; m < 4; ++m) { bf16_t* rowp = O + (size_t)(row0 + ai * HALF + m * 16) * ldc + col0;
                const float s = tab[p.buf * 256 + wr * 64 + fr + ai * HALF + m * 16];
                const f32x4 G0 = __builtin_convertvector(__builtin_bit_cast(i32x4, acc[ai][0][m][0]), f32x4) * (cg0 * s), G1 = __builtin_convertvector(__builtin_bit_cast(i32x4, acc[ai][0][m][1]), f32x4) * (cg1 * s);
                const f32x4 U0 = __builtin_convertvector(__builtin_bit_cast(i32x4, acc[ai][1][m][0]), f32x4) * (cu0 * s), U1 = __builtin_convertvector(__builtin_bit_cast(i32x4, acc[ai][1][m][1]), f32x4) * (cu1 * s);
                f32x4 e0, e1, r0, r1;
#pragma unroll
                for (int k = 0; k < 4; ++k) { e0[k] = __builtin_amdgcn_exp2f(-G0[k]); e1[k] = __builtin_amdgcn_exp2f(-G1[k]); }
                const f32x4 d0 = e0 + 1.0f, d1 = e1 + 1.0f, p0 = G0 * U0, p1 = G1 * U1;
#pragma unroll
                for (int k = 0; k < 4; ++k) { r0[k] = __builtin_amdgcn_rcpf(d0[k]); r1[k] = __builtin_amdgcn_rcpf(d1[k]); }
                const f32x4 o0 = p0 * r0, o1 = p1 * r1;
                u32x4 w; w.x = cvt_pk_bf16(o0[0], o0[1]); w.y = cvt_pk_bf16(o0[2], o0[3]); w.z = cvt_pk_bf16(o1[0], o1[1]); w.w = cvt_pk_bf16(o1[2], o1[3]);
                *(u32x4*)rowp = w; }
    }
};

struct EpiBf16I8 {
    static constexpr bool PERM = true, AFTER_DRAIN = false;
    typedef RowPre Pre;
    bf16_t* O; int ldc; const float* rs; const float* cs; PG8_LAS float* tab; PG8_LAS float* ctab;
    __device__ __forceinline__ void preload(Pre& p, const Unit& u, int wid, int lane, int ui) const {
        p.buf = ui & 1;
        if (wid < 4) __builtin_amdgcn_global_load_lds((const unsigned*)(rs + u.pm * BM + wid * 64 + lane), (PG8_LAS unsigned*)(tab + p.buf * 256 + wid * 64), 4, 0, 0);
        else __builtin_amdgcn_global_load_lds((const unsigned*)(cs + u.pn * BM + (wid - 4) * 64 + lane), (PG8_LAS unsigned*)(ctab + p.buf * 256 + (wid - 4) * 64), 4, 0, 0);
    }
    __device__ __forceinline__ void operator()(const f32x4 (&acc)[2][2][4][2], const Unit& u, int wr, int wc, int fr, int fq, const Pre& p) const {
        const int row0 = u.pm * BM + wr * 64 + fr, col0 = u.pn * BM + wc * 32 + 8 * fq;
        const PG8_LAS float* cg = ctab + p.buf * 256 + wc * 32 + 8 * fq;
        f32x4 cc[2][2];
#pragma unroll
        for (int bj = 0; bj < 2; ++bj) { cc[bj][0] = *(const PG8_LAS f32x4*)(cg + bj * HALF); cc[bj][1] = *(const PG8_LAS f32x4*)(cg + bj * HALF + 4); }
#pragma unroll
        for (int ai = 0; ai < 2; ++ai)
#pragma unroll
            for (int m = 0; m < 4; ++m) { bf16_t* rowp = O + (size_t)(row0 + ai * HALF + m * 16) * ldc + col0; const float s = tab[p.buf * 256 + wr * 64 + fr + ai * HALF + m * 16];
#pragma unroll
                for (int bj = 0; bj < 2; ++bj) { const f32x4 v0 = __builtin_convertvector(__builtin_bit_cast(i32x4, acc[ai][bj][m][0]), f32x4) * (cc[bj][0] * s), v1 = __builtin_convertvector(__builtin_bit_cast(i32x4, acc[ai][bj][m][1]), f32x4) * (cc[bj][1] * s);
                    u32x4 w; w.x = cvt_pk_bf16(v0[0], v0[1]); w.y = cvt_pk_bf16(v0[2], v0[3]); w.z = cvt_pk_bf16(v1[0], v1[1]); w.w = cvt_pk_bf16(v1[2], v1[3]);
                    *(u32x4*)(rowp + bj * HALF) = w; } }
    }
};

template <class Epi, class Sched, bool ALIGN_EPI = false, bool SP2 = false, bool I8 = false>
__device__ __forceinline__ void gemm_phase(PG8_LAS unsigned char* lds, const Gemm g, const Sched& S, const Epi& E) {
    int tid_ = threadIdx.x; asm volatile("" : "+v"(tid_));
    const int tid = tid_, wid = __builtin_amdgcn_readfirstlane(tid >> 6), lane = tid & 63, wr = wid >> 2, wc = wid & 3, fr = lane & 15, fq = lane >> 4;
    const int K = g.K, nt = K / BK;
    unsigned voffA[2], voffB[2];
#pragma unroll
    for (int i = 0; i < 2; ++i) { int R, C; stage_rc(tid * 16 + i * 8192, R, C); const int Rb = Epi::PERM ? ((R & ~31) + perm32(R & 31)) : R;
        voffA[i] = (unsigned)(R * K + C) * 2u; voffB[i] = (unsigned)(Rb * K + C) * 2u; }
    const size_t kstep = (size_t)(BK * 2);
    const size_t hstep = (size_t)HALF * K * 2;
    const size_t tstep = 2 * hstep;
    const unsigned ldsw = (unsigned)wid * 1024u;
    const int aoff = lds_byte(wr * 64 + fr, fq * 8), boff = lds_byte(wc * 32 + fr, fq * 8);
#define PG8_SA(b, h) (((b) * 2 + (h)) * HTB)
#define PG8_SB(b, h) ((4 + (b) * 2 + (h)) * HTB)
#define PG8_STAGE(bufoff, gbase, voff) do { _Pragma("unroll") for (int _i = 0; _i < 2; ++_i) \
        __builtin_amdgcn_global_load_lds((const unsigned*)((const char*)(gbase) + (voff)[_i]), (PG8_LAS unsigned*)(lds + (bufoff) + ldsw + _i * 8192), 16, 0, 0); } while (0)
#define PG8_LDA(dst, b, h) do { _Pragma("unroll") for (int m = 0; m < 4; ++m) _Pragma("unroll") for (int k = 0; k < 2; ++k) dst[m][k] = *(const PG8_LAS bf16x8*)(lds + PG8_SA(b, h) + aoff + m * 2048 + k * 1024); } while (0)
#define PG8_LDB(dst, b, h) do { _Pragma("unroll") for (int n = 0; n < 2; ++n) _Pragma("unroll") for (int k = 0; k < 2; ++k) dst[n][k] = *(const PG8_LAS bf16x8*)(lds + PG8_SB(b, h) + boff + n * 2048 + k * 1024); } while (0)
#define PG8_MMA(ai, bj, At, Bt) do { __builtin_amdgcn_s_setprio(1); _Pragma("unroll") for (int m = 0; m < 4; ++m) _Pragma("unroll") for (int n = 0; n < 2; ++n) _Pragma("unroll") for (int k = 0; k < 2; ++k) \
        { if constexpr (I8) acc[ai][bj][m][n] = __builtin_bit_cast(f32x4, __builtin_amdgcn_mfma_i32_16x16x64_i8(__builtin_bit_cast(i32x4, Bt[n][k]), __builtin_bit_cast(i32x4, At[m][k]), __builtin_bit_cast(i32x4, acc[ai][bj][m][n]), 0, 0, 0)); \
          else acc[ai][bj][m][n] = __builtin_amdgcn_mfma_f32_16x16x32_bf16(Bt[n][k], At[m][k], acc[ai][bj][m][n], 0, 0, 0); } __builtin_amdgcn_s_setprio(0); } while (0)
#define PG8_WAIT_V(n) asm volatile("s_waitcnt vmcnt(" #n ")" ::: "memory")
#define PG8_WAIT_L(n) asm volatile("s_waitcnt lgkmcnt(" #n ")" ::: "memory")
#define PG8_BAR __builtin_amdgcn_s_barrier()
#define PG8_SCHED __builtin_amdgcn_sched_barrier(0)
    Unit cur, nxt; int ui = 0;
    if (!S.next(0, cur)) return;
    f32x4 acc[2][2][4][2];
#pragma unroll
    for (int a = 0; a < 2; ++a)
#pragma unroll
        for (int b = 0; b < 2; ++b)
#pragma unroll
            for (int m = 0; m < 4; ++m)
#pragma unroll
                for (int n = 0; n < 2; ++n) acc[a][b][m][n] = (f32x4){0.f, 0.f, 0.f, 0.f};
    bf16x8 At[4][2], B0[2][2], B1[2][2];
    const char* cA = (const char*)g.A + (size_t)cur.pm * tstep; const char* cB = (const char*)g.Bt + (size_t)cur.pn * tstep;
    S.a_ready(cur);
    typename Epi::Pre pre; E.preload(pre, cur, wid, lane, ui);
    if constexpr (SP2) {
        PG8_STAGE(PG8_SB(0, 0), cB, voffB); PG8_STAGE(PG8_SB(0, 1), cB + hstep, voffB); PG8_STAGE(PG8_SA(0, 0), cA, voffA); PG8_STAGE(PG8_SA(0, 1), cA + hstep, voffA);
        if (wr == 1) PG8_BAR;
        PG8_WAIT_V(2); PG8_BAR;
        PG8_STAGE(PG8_SB(1, 0), cB + kstep, voffB); PG8_STAGE(PG8_SA(1, 0), cA + kstep, voffA); PG8_STAGE(PG8_SB(1, 1), cB + hstep + kstep, voffB);
        PG8_WAIT_V(6); PG8_BAR;
    } else {
        PG8_STAGE(PG8_SB(0, 0), cB, voffB); PG8_STAGE(PG8_SA(0, 0), cA, voffA); PG8_STAGE(PG8_SB(0, 1), cB + hstep, voffB); PG8_STAGE(PG8_SA(0, 1), cA + hstep, voffA);
        if (wr == 1) PG8_BAR;
        PG8_WAIT_V(4); PG8_BAR;
        PG8_STAGE(PG8_SB(1, 0), cB + kstep, voffB); PG8_STAGE(PG8_SA(1, 0), cA + kstep, voffA); PG8_STAGE(PG8_SB(1, 1), cB + hstep + kstep, voffB);
        PG8_WAIT_V(6); PG8_BAR;
    }
    for (;;) {
        const bool has_next = S.next(ui + 1, nxt);
        const char* nA = has_next ? (const char*)g.A + (size_t)nxt.pm * tstep : cA; const char* nB = has_next ? (const char*)g.Bt + (size_t)nxt.pn * tstep : cB;
        for (int t = 0; t < nt; t += 2) {
            const bool last = (t == nt - 2);
            const char* a1 = cA + (size_t)(t + 1) * kstep;
            const char* a2 = last ? nA : cA + (size_t)(t + 2) * kstep; const char* b2 = last ? nB : cB + (size_t)(t + 2) * kstep;
            const char* a3 = a2 + kstep; const char* b3 = b2 + kstep;
            if (last && has_next) S.a_ready(nxt);
            if constexpr (SP2) {
            PG8_LDB(B0, 0, 0); PG8_LDB(B1, 0, 1); PG8_SCHED; PG8_LDA(At, 0, 0); PG8_STAGE(PG8_SA(1, 1), a1 + hstep, voffA);
            PG8_WAIT_V(8); PG8_WAIT_L(0); PG8_BAR; PG8_MMA(0, 0, At, B0); PG8_MMA(0, 1, At, B1); PG8_BAR; PG8_SCHED;
            PG8_LDA(At, 0, 1); PG8_STAGE(PG8_SB(0, 0), b2, voffB); PG8_STAGE(PG8_SB(0, 1), b2 + hstep, voffB); PG8_STAGE(PG8_SA(0, 0), a2, voffA);
            PG8_WAIT_V(8); PG8_WAIT_L(0); PG8_BAR; PG8_MMA(1, 0, At, B0); PG8_MMA(1, 1, At, B1); PG8_BAR; PG8_SCHED;
            PG8_LDB(B0, 1, 0); PG8_LDB(B1, 1, 1); PG8_SCHED; PG8_LDA(At, 1, 0); PG8_STAGE(PG8_SA(0, 1), a2 + hstep, voffA);
            PG8_WAIT_V(8); PG8_WAIT_L(0); PG8_BAR; PG8_MMA(0, 0, At, B0); PG8_MMA(0, 1, At, B1); PG8_BAR; PG8_SCHED;
            PG8_LDA(At, 1, 1); PG8_STAGE(PG8_SB(1, 0), b3, voffB); PG8_STAGE(PG8_SB(1, 1), b3 + hstep, voffB); PG8_STAGE(PG8_SA(1, 0), a3, voffA);
            PG8_WAIT_V(8); PG8_WAIT_L(0); PG8_BAR; PG8_MMA(1, 0, At, B0); PG8_MMA(1, 1, At, B1); PG8_BAR; PG8_SCHED;
            } else {
            PG8_LDB(B0, 0, 0); PG8_SCHED; PG8_LDA(At, 0, 0); PG8_STAGE(PG8_SA(1, 1), a1 + hstep, voffA);
            PG8_WAIT_L(8); PG8_BAR; PG8_WAIT_L(0); PG8_MMA(0, 0, At, B0); PG8_BAR; PG8_SCHED;
            PG8_LDB(B1, 0, 1); PG8_STAGE(PG8_SB(0, 0), b2, voffB);
            PG8_BAR; PG8_WAIT_L(0); PG8_MMA(0, 1, At, B1); PG8_BAR;
            PG8_LDA(At, 0, 1); PG8_STAGE(PG8_SA(0, 0), a2, voffA);
            PG8_BAR; PG8_WAIT_L(0); PG8_MMA(1, 0, At, B0); PG8_BAR; PG8_SCHED;
            PG8_STAGE(PG8_SB(0, 1), b2 + hstep, voffB);
            PG8_WAIT_V(6); PG8_BAR; PG8_MMA(1, 1, At, B1); PG8_BAR;
            PG8_LDB(B0, 1, 0); PG8_SCHED; PG8_LDA(At, 1, 0); PG8_STAGE(PG8_SA(0, 1), a2 + hstep, voffA);
            PG8_WAIT_L(8); PG8_BAR; PG8_WAIT_L(0); PG8_MMA(0, 0, At, B0); PG8_BAR; PG8_SCHED;
            PG8_LDB(B1, 1, 1); PG8_STAGE(PG8_SB(1, 0), b3, voffB);
            PG8_BAR; PG8_WAIT_L(0); PG8_MMA(0, 1, At, B1); PG8_BAR;
            PG8_LDA(At, 1, 1); PG8_STAGE(PG8_SA(1, 0), a3, voffA);
            PG8_BAR; PG8_WAIT_L(0); PG8_MMA(1, 0, At, B0); PG8_BAR; PG8_SCHED;
            PG8_STAGE(PG8_SB(1, 1), b3 + hstep, voffB);
            PG8_WAIT_V(6); PG8_BAR; PG8_MMA(1, 1, At, B1); PG8_BAR;
            }
        }
        if constexpr (ALIGN_EPI) { if (wr == 0) PG8_BAR; }
        if constexpr (!Epi::AFTER_DRAIN) { E(acc, cur, wr, wc, fr, fq, pre); S.done(cur); }
        if (!has_next) break;
#pragma unroll
        for (int a = 0; a < 2; ++a)
#pragma unroll
            for (int b = 0; b < 2; ++b)
#pragma unroll
                for (int m = 0; m < 4; ++m)
#pragma unroll
                    for (int n = 0; n < 2; ++n) acc[a][b][m][n] = (f32x4){0.f, 0.f, 0.f, 0.f};
        cur = nxt; cA = nA; cB = nB; ++ui;
        E.preload(pre, cur, wid, lane, ui);
        if constexpr (ALIGN_EPI) { if (wr == 1) PG8_BAR; }
    }
    PG8_WAIT_V(0);
    if constexpr (!ALIGN_EPI) { if (wr == 0) PG8_BAR; }
    PG8_BAR;
    if constexpr (Epi::AFTER_DRAIN) { E.fused(acc, cur, wr, wc, fr, fq, lds, wid, lane); S.done(cur); }
#undef PG8_SA
#undef PG8_SB
#undef PG8_STAGE
#undef PG8_LDA
#undef PG8_LDB
#undef PG8_MMA
#undef PG8_WAIT_V
#undef PG8_WAIT_L
#undef PG8_BAR
#undef PG8_SCHED
}
}
#define GAS __attribute__((address_space(1)))
#define LAS __attribute__((address_space(3)))
typedef unsigned short bf16;
typedef unsigned v4u __attribute__((ext_vector_type(4)));
typedef float f32x4 __attribute__((ext_vector_type(4)));
typedef short bf16x8 __attribute__((ext_vector_type(8)));
typedef GAS unsigned gu32;
typedef GAS unsigned long long gu64;
#define RLX_AGENT __ATOMIC_RELAXED, __HIP_MEMORY_SCOPE_AGENT
#define LDS_WAIT() asm volatile("s_waitcnt lgkmcnt(0)" ::: "memory")
#define VM_WAIT() asm volatile("s_waitcnt vmcnt(0)" ::: "memory")
__device__ __forceinline__ unsigned long long rt() { return __builtin_amdgcn_s_memrealtime(); }
__device__ __forceinline__ unsigned f2bf(float f) { unsigned u = __builtin_bit_cast(unsigned, f); return (u + 0x7fffu + ((u >> 16) & 1u)) >> 16; }
__device__ __forceinline__ unsigned pk2(float lo, float hi) { return f2bf(lo) | (f2bf(hi) << 16); }

#define XB_TMO      128
#define XB_XCNT(j)  (256  + 64 * (j))
#define XB_XSUB(j)  (1280 + 64 * (j))
#define XB_XGEN(j)  (2304 + 64 * (j))
#define XB_TOP      3328
#define XB_TOPGEN   3392
#define XCD_BAR_WORDS 3456
#define XB_SPIN_CAP (1u << 18)

__device__ __forceinline__ unsigned xb_ld(unsigned* p)              { return __hip_atomic_load(p, __ATOMIC_RELAXED, __HIP_MEMORY_SCOPE_AGENT); }
__device__ __forceinline__ unsigned xb_add(unsigned* p, unsigned v) { return __hip_atomic_fetch_add(p, v, __ATOMIC_RELAXED, __HIP_MEMORY_SCOPE_AGENT); }
__device__ __forceinline__ unsigned xb_xcc_id() { return (unsigned)__builtin_amdgcn_s_getreg((3 << 11) | 20) & 0xFu; }
#define XB_SPIN(cond, bar) do { unsigned _sp = 0; while (cond) { __builtin_amdgcn_s_sleep(1); \
    if ((++_sp & 255u) == 0u) { if (xb_ld(&(bar)[XB_TMO])) break; if (_sp > XB_SPIN_CAP) { atomicAdd(&(bar)[XB_TMO], 1u); break; } } } } while (0)

struct XcdBarrier {
    unsigned* bar; unsigned x;
    volatile LAS unsigned* st;
};

__device__ __forceinline__ XcdBarrier xcd_barrier_post(unsigned* bar, volatile LAS unsigned* st) {
    XcdBarrier b; b.bar = bar; b.x = xb_xcc_id(); b.st = st;
    if (threadIdx.x == 0) (void)xb_add(&bar[XB_XCNT(b.x)], 1u);
    return b;
}
__device__ __forceinline__ void xcd_barrier_complete(unsigned* bar, unsigned x, unsigned& nloc, unsigned& nx) {
    const unsigned G = gridDim.x * gridDim.y * gridDim.z;
    unsigned sum, cnt, mine, sp = 0u;
    for (;;) {
        sum = 0u; cnt = 0u; mine = 0u;
#pragma unroll
        for (unsigned j = 0; j < 16; ++j) { const unsigned c = xb_ld(&bar[XB_XCNT(j)]); sum += c; cnt += (c > 0u) ? 1u : 0u; mine = (j == x) ? c : mine; }
        if (sum == G) break;
        __builtin_amdgcn_s_sleep(1);
        if ((++sp & 255u) == 0u) { if (xb_ld(&bar[XB_TMO])) break; if (sp > XB_SPIN_CAP) { atomicAdd(&bar[XB_TMO], 1u); break; } }
    }
    nloc = mine > 0u ? mine : 1u; nx = cnt > 0u ? cnt : 1u;
}

__device__ __forceinline__ void xcd_barrier(const XcdBarrier& b) {
    asm volatile("s_waitcnt vmcnt(0)" ::: "memory");
    __syncthreads();
    if (threadIdx.x == 0) {
        unsigned* bar = b.bar;
        __builtin_amdgcn_s_waitcnt(0);
        unsigned nloc = b.st[0], nx = b.st[1];
        if (nloc == 0u) { xcd_barrier_complete(bar, b.x, nloc, nx); b.st[0] = nloc; b.st[1] = nx; }
        const unsigned old = xb_add(&bar[XB_XSUB(b.x)], 1u);
        const unsigned gen = old / nloc;
        if (old + 1u == (gen + 1u) * nloc) {
            __builtin_amdgcn_fence(__ATOMIC_RELEASE, "agent");
            asm volatile("s_waitcnt vmcnt(0)" ::: "memory");
            const unsigned og = xb_add(&bar[XB_TOP], 1u);
            const unsigned tg = og / nx;
            if (og + 1u == (tg + 1u) * nx) xb_add(&bar[XB_TOPGEN], 1u);
            else XB_SPIN(xb_ld(&bar[XB_TOPGEN]) == tg, bar);
            __builtin_amdgcn_fence(__ATOMIC_ACQUIRE, "agent");
            xb_add(&bar[XB_XGEN(b.x)], 1u);
            asm volatile("s_waitcnt vmcnt(0)" ::: "memory");
        } else {
            XB_SPIN(xb_ld(&bar[XB_XGEN(b.x)]) == gen, bar);
            __builtin_amdgcn_fence(__ATOMIC_ACQUIRE, "agent");
            asm volatile("s_waitcnt vmcnt(0)" ::: "memory");
        }
    }
    __syncthreads();
}
typedef unsigned v2u __attribute__((ext_vector_type(2)));
__device__ __forceinline__ float bf_lo(unsigned w) { return __uint_as_float(w << 16); }
__device__ __forceinline__ float bf_hi(unsigned w) { return __uint_as_float(w & 0xffff0000u); }

constexpr int NWAVES = 8;
constexpr int SEQ = 8192, DM = 2048, DFF = 5632, DEPTH = 4, NH = 12, HD = 128, NMEM = 256, NMH = 4;
constexpr int SELF_W = NH * HD, IN_W = 3 * SELF_W + NMH * HD, KVW = 2 * NMH * HD;
constexpr int LDP = IN_W + KVW;
constexpr int MROWS = SEQ + NMEM;
constexpr int QCOL = 0, KCOL = SELF_W, VCOL = 2 * SELF_W, QMCOL = 3 * SELF_W, KMCOL = IN_W, VMCOL = IN_W + NMH * HD;
constexpr float RMS_EPS = 1e-6f, SCALE = 0.08838834764831845f;
constexpr int MOBA_BLK = 256, MOBA_NB = SEQ / MOBA_BLK;

constexpr size_t MiB = 1u << 20;
constexpr size_t WS_CTL = 0, CTL_ZERO_BYTES = 256 * 1024;
constexpr size_t WS_KMEAN = 1 * MiB;
constexpr size_t WS_LSE = 1 * MiB + 256 * 1024;
constexpr size_t WS_RSTD = 1 * MiB + 640 * 1024;
constexpr size_t WS_W = 2 * MiB, LW = 164 * MiB;
constexpr size_t LW_IN = 0, LW_OUT = 88 * MiB, LW_QKV = 132 * MiB, LW_O = 156 * MiB;
constexpr size_t WS_H = WS_W + DEPTH * LW;
constexpr size_t WS_A = WS_H + 33 * MiB;
constexpr size_t WS_F = WS_A + 88 * MiB;
constexpr size_t WS_P = WS_F + 64 * MiB;
constexpr size_t WS_CAT = WS_P + 99 * MiB;
constexpr size_t WS_SEL = WS_CAT + 32 * MiB;
constexpr size_t WS_PLSE = WS_SEL + 1 * MiB;
constexpr size_t WS_LIST = WS_PLSE + 2 * MiB;
constexpr size_t WS_PART = WS_LIST + 12 * MiB;
constexpr size_t WS_SLOT1 = WS_PART + 96 * MiB, WS_SLOT2 = WS_SLOT1 + 256 * 1024;
constexpr size_t WS_END = WS_SLOT1 + 1 * MiB;
static_assert((size_t)MROWS * DM * 2 == 33 * MiB && (size_t)SEQ * DFF * 2 == 88 * MiB && (size_t)MROWS * LDP * 2 == 99 * MiB && (size_t)2 * DFF * DM * 2 == 44 * MiB && (size_t)LDP * DM * 2 == 24 * MiB, "ws map");
constexpr int CW_X1 = 16384, CW_X2 = 16384 + 2048;
constexpr int CW_CNT = 8192;
constexpr int CW_BAR = 4096;

constexpr int RING_OFF = 0, RING_BYTES = 131072;
constexpr int LDSCTL_OFF = RING_BYTES, MISC_OFF = LDSCTL_OFF + 320;
constexpr int RSTAB_OFF = RING_BYTES + 1024;
constexpr int CSTAB_OFF = RSTAB_OFF + 2048;
constexpr int CMAX_OFF = RING_BYTES + 8192;
constexpr int LDS_BYTES = 147456;

struct Ctx {
    LAS unsigned char* lds;
    int tid, lane, wave, vcu, G;
};

#define WAVE_SYNC() do { asm volatile("s_waitcnt lgkmcnt(0)" ::: "memory"); __builtin_amdgcn_wave_barrier(); asm volatile("" ::: "memory"); } while (0)
__device__ __forceinline__ float wave_sum(float v) {
#pragma unroll
    for (int o = 1; o < 64; o <<= 1) v += __shfl_xor(v, o);
    return v;
}
__device__ __forceinline__ float wave_max(float v) {
#pragma unroll
    for (int o = 1; o < 64; o <<= 1) v = fmaxf(v, __shfl_xor(v, o));
    return v;
}

__device__ __forceinline__ void p0_transpose_item(const float* W, int K, int N, bf16* WT, int k0, int n0, int drow0, LAS float* scr, int lane, const float* gk) {
    (void)scr;
    const int r8 = lane >> 3, cg = lane & 7;
    f32x4 wv[8];
    const float* wp = W + (size_t)(k0 + 8 * r8) * N + n0 + 4 * cg;
#pragma unroll
    for (int i = 0; i < 8; ++i) wv[i] = __builtin_nontemporal_load((const f32x4*)(wp + (size_t)i * N));
    if (gk) { const f32x4 ga = *(const GAS f32x4*)(gk + k0 + 8 * r8), gb = *(const GAS f32x4*)(gk + k0 + 8 * r8 + 4);
        wv[0] = wv[0] * ga.x; wv[1] = wv[1] * ga.y; wv[2] = wv[2] * ga.z; wv[3] = wv[3] * ga.w; wv[4] = wv[4] * gb.x; wv[5] = wv[5] * gb.y; wv[6] = wv[6] * gb.z; wv[7] = wv[7] * gb.w; }
#pragma unroll
    for (int e = 0; e < 4; ++e) { v4u o; o.x = pk2(wv[0][e], wv[1][e]); o.y = pk2(wv[2][e], wv[3][e]); o.z = pk2(wv[4][e], wv[5][e]); o.w = pk2(wv[6][e], wv[7][e]);
        *(GAS v4u*)(WT + (size_t)(drow0 + 4 * cg + e) * K + k0 + 8 * r8) = o; }
}

__device__ __forceinline__ unsigned q8pack(float a, float b, float c, float d, float inv) {
    const float M = 12582912.0f;
    const unsigned fa = __float_as_uint(fmaf(a, inv, M)), fb = __float_as_uint(fmaf(b, inv, M)), fc = __float_as_uint(fmaf(c, inv, M)), fd = __float_as_uint(fmaf(d, inv, M));
    const unsigned t01 = __builtin_amdgcn_perm(fb, fa, 0x0c0c0400u), t23 = __builtin_amdgcn_perm(fd, fc, 0x0c0c0400u);
    return (t23 << 16) | t01;
}
__device__ __forceinline__ void strip_convert8(const float* W, int N, const float* gk, unsigned char* W8, float* cs, int n0, int drow0, LAS float* scr, LAS float* cm, int wave, int lane, const float csmul = 1.0f) {
    const int kw = 256 * wave, r8 = lane >> 3, cg = lane & 7;
    LAS float* gt = scr;
    *(LAS f32x4*)(gt + 4 * lane) = gk ? *(const GAS f32x4*)(gk + kw + 4 * lane) : (f32x4){1.f, 1.f, 1.f, 1.f};
    f32x4 wv[32];
    const float* wp = W + (size_t)(kw + 32 * r8) * N + n0 + 4 * cg;
#pragma unroll
    for (int i = 0; i < 32; ++i) wv[i] = __builtin_nontemporal_load((const f32x4*)(wp + (size_t)i * N));
    WAVE_SYNC();
    f32x4 mx4 = (f32x4){0.f, 0.f, 0.f, 0.f};
#pragma unroll
    for (int i4 = 0; i4 < 8; ++i4) { const f32x4 g4 = *(const LAS f32x4*)(gt + 32 * r8 + 4 * i4);
#pragma unroll
        for (int t = 0; t < 4; ++t) { const int i = 4 * i4 + t; wv[i] = wv[i] * g4[t]; mx4.x = fmaxf(mx4.x, fabsf(wv[i].x)); mx4.y = fmaxf(mx4.y, fabsf(wv[i].y)); mx4.z = fmaxf(mx4.z, fabsf(wv[i].z)); mx4.w = fmaxf(mx4.w, fabsf(wv[i].w)); } }
#pragma unroll
    for (int o = 8; o < 64; o <<= 1) { mx4.x = fmaxf(mx4.x, __shfl_xor(mx4.x, o)); mx4.y = fmaxf(mx4.y, __shfl_xor(mx4.y, o)); mx4.z = fmaxf(mx4.z, __shfl_xor(mx4.z, o)); mx4.w = fmaxf(mx4.w, __shfl_xor(mx4.w, o)); }
    if (lane < 8) *(LAS f32x4*)(cm + wave * 32 + 4 * lane) = mx4;
    __syncthreads();
    f32x4 m8 = (f32x4){0.f, 0.f, 0.f, 0.f};
#pragma unroll
    for (int w = 0; w < 8; ++w) { const f32x4 c4 = *(const LAS f32x4*)(cm + w * 32 + 4 * cg); m8.x = fmaxf(m8.x, c4.x); m8.y = fmaxf(m8.y, c4.y); m8.z = fmaxf(m8.z, c4.z); m8.w = fmaxf(m8.w, c4.w); }
    if (wave == 0 && lane < 8) *(GAS f32x4*)(cs + drow0 + 4 * cg) = m8 * ((1.0f / 127.0f) * csmul);
    float inv[4] = {m8.x > 0.f ? 127.0f / m8.x : 0.f, m8.y > 0.f ? 127.0f / m8.y : 0.f, m8.z > 0.f ? 127.0f / m8.z : 0.f, m8.w > 0.f ? 127.0f / m8.w : 0.f};
#pragma unroll
    for (int e = 0; e < 4; ++e)
#pragma unroll
        for (int h = 0; h < 2; ++h) { const int b = 16 * h; v4u o;
            o.x = q8pack(wv[b + 0][e], wv[b + 1][e], wv[b + 2][e], wv[b + 3][e], inv[e]); o.y = q8pack(wv[b + 4][e], wv[b + 5][e], wv[b + 6][e], wv[b + 7][e], inv[e]);
            o.z = q8pack(wv[b + 8][e], wv[b + 9][e], wv[b + 10][e], wv[b + 11][e], inv[e]); o.w = q8pack(wv[b + 12][e], wv[b + 13][e], wv[b + 14][e], wv[b + 15][e], inv[e]);
            *(GAS v4u*)(W8 + (size_t)(drow0 + 4 * cg + e) * 2048 + kw + 32 * r8 + b) = o; }
    __syncthreads();
}

__device__ __forceinline__ void cast_row(const float* src, bf16* xb, float* rs, int lane, unsigned char* x8, float* rs8) {
    const GAS f32x4* xr = (const GAS f32x4*)src + lane; f32x4 v[8]; float ss = 0.f;
#pragma unroll
    for (int j = 0; j < 8; ++j) { v[j] = xr[64 * j]; ss += (v[j].x * v[j].x + v[j].y * v[j].y) + (v[j].z * v[j].z + v[j].w * v[j].w); }
    GAS v2u* o8 = (GAS v2u*)xb + lane;
#pragma unroll
    for (int j = 0; j < 8; ++j) { v2u o; o.x = pk2(v[j].x, v[j].y); o.y = pk2(v[j].z, v[j].w); o8[64 * j] = o; }
    const float r = 1.0f / sqrtf(wave_sum(ss) * (1.0f / DM) + RMS_EPS);
    if (lane == 0) *rs = r;
    if (x8) { float mx = 0.f;
#pragma unroll
        for (int j = 0; j < 8; ++j) mx = fmaxf(fmaxf(mx, fmaxf(fabsf(v[j].x), fabsf(v[j].y))), fmaxf(fabsf(v[j].z), fabsf(v[j].w)));
        mx = wave_max(mx); const float inv = mx > 0.f ? 127.0f / mx : 0.f; GAS unsigned* q = (GAS unsigned*)x8 + lane;
#pragma unroll
        for (int j = 0; j < 8; ++j) q[64 * j] = q8pack(v[j].x, v[j].y, v[j].z, v[j].w, inv);
        if (lane == 0) *rs8 = r * mx * (1.0f / 127.0f); }
}
__device__ __forceinline__ float sq8(const v4u w) { return (bf_lo(w.x) * bf_lo(w.x) + bf_hi(w.x) * bf_hi(w.x)) + (bf_lo(w.y) * bf_lo(w.y) + bf_hi(w.y) * bf_hi(w.y)) + (bf_lo(w.z) * bf_lo(w.z) + bf_hi(w.z) * bf_hi(w.z)) + (bf_lo(w.w) * bf_lo(w.w) + bf_hi(w.w) * bf_hi(w.w)); }
template <int R>
__device__ __forceinline__ void thin_rows(bf16* xb0, const bf16* f0, const float* gpost, float coef, float* rs0, float* xout0, int m0, int mstep, int mend, int lane, unsigned char* x8_0, float* rs8_0) {
    v4u xv[R][4], fv[R][4]; f32x4 g0[4], g1[4];
    const GAS f32x4* gp = (const GAS f32x4*)gpost + 2 * lane;
#pragma unroll
    for (int i = 0; i < R; ++i) { const int m = m0 + i * mstep; if (m < mend) { const GAS v4u* fr = (const GAS v4u*)(f0 + (size_t)m * DM) + lane; const GAS v4u* xr = (const GAS v4u*)(xb0 + (size_t)m * DM) + lane;
#pragma unroll
        for (int j = 0; j < 4; ++j) { fv[i][j] = fr[64 * j]; xv[i][j] = xr[64 * j]; } } }
#pragma unroll
    for (int j = 0; j < 4; ++j) { g0[j] = gp[128 * j]; g1[j] = gp[128 * j + 1]; }
    float ss[R];
#pragma unroll
    for (int i = 0; i < R; ++i) { ss[i] = 0.f; if (m0 + i * mstep < mend) {
#pragma unroll
        for (int j = 0; j < 4; ++j) ss[i] += sq8(fv[i][j]); } }
#pragma unroll
    for (int o = 1; o < 64; o <<= 1)
#pragma unroll
        for (int i = 0; i < R; ++i) ss[i] += __shfl_xor(ss[i], o);
    float s2[R], ymx[R], rr[R];
#pragma unroll
    for (int i = 0; i < R; ++i) { s2[i] = 0.f; ymx[i] = 0.f; rr[i] = 0.f; const int m = m0 + i * mstep; if (m < mend) { const float r = coef / sqrtf(ss[i] * (1.0f / DM) + RMS_EPS); rr[i] = r;
        GAS v4u* xr = (GAS v4u*)(xb0 + (size_t)m * DM) + lane;
#pragma unroll
        for (int j = 0; j < 4; ++j) { const v4u w = fv[i][j], x = xv[i][j];
            const float y0 = bf_lo(x.x) + bf_lo(w.x) * r * g0[j].x, y1 = bf_hi(x.x) + bf_hi(w.x) * r * g0[j].y, y2 = bf_lo(x.y) + bf_lo(w.y) * r * g0[j].z, y3 = bf_hi(x.y) + bf_hi(w.y) * r * g0[j].w;
            const float y4 = bf_lo(x.z) + bf_lo(w.z) * r * g1[j].x, y5 = bf_hi(x.z) + bf_hi(w.z) * r * g1[j].y, y6 = bf_lo(x.w) + bf_lo(w.w) * r * g1[j].z, y7 = bf_hi(x.w) + bf_hi(w.w) * r * g1[j].w;
            s2[i] += (y0 * y0 + y1 * y1) + (y2 * y2 + y3 * y3) + (y4 * y4 + y5 * y5) + (y6 * y6 + y7 * y7);
            ymx[i] = fmaxf(fmaxf(fmaxf(ymx[i], fmaxf(fabsf(y0), fabsf(y1))), fmaxf(fabsf(y2), fabsf(y3))), fmaxf(fmaxf(fabsf(y4), fabsf(y5)), fmaxf(fabsf(y6), fabsf(y7))));
            if (!xout0) { v4u o; o.x = pk2(y0, y1); o.y = pk2(y2, y3); o.z = pk2(y4, y5); o.w = pk2(y6, y7); xr[64 * j] = o; }
            if (xout0) { GAS f32x4* xo = (GAS f32x4*)(xout0 + (size_t)m * DM) + 2 * lane + 128 * j; xo[0] = (f32x4){y0, y1, y2, y3}; xo[1] = (f32x4){y4, y5, y6, y7}; } } } }
#pragma unroll
    for (int o = 1; o < 64; o <<= 1)
#pragma unroll
        for (int i = 0; i < R; ++i) s2[i] += __shfl_xor(s2[i], o);
#pragma unroll
    for (int i = 0; i < R; ++i) { const int m = m0 + i * mstep; if (m < mend && lane == 0 && !xout0) rs0[m] = 1.0f / sqrtf(s2[i] * (1.0f / DM) + RMS_EPS); }
    if (x8_0) {
#pragma unroll
        for (int o = 1; o < 64; o <<= 1)
#pragma unroll
            for (int i = 0; i < R; ++i) ymx[i] = fmaxf(ymx[i], __shfl_xor(ymx[i], o));
#pragma unroll
        for (int i = 0; i < R; ++i) { const int m = m0 + i * mstep; if (m < mend) { const float r = rr[i], inv = ymx[i] > 0.f ? 127.0f / ymx[i] : 0.f;
            GAS v2u* q = (GAS v2u*)(x8_0 + (size_t)m * DM) + lane;
#pragma unroll
            for (int j = 0; j < 4; ++j) { const v4u w = fv[i][j], x = xv[i][j];
                const float y0 = bf_lo(x.x) + bf_lo(w.x) * r * g0[j].x, y1 = bf_hi(x.x) + bf_hi(w.x) * r * g0[j].y, y2 = bf_lo(x.y) + bf_lo(w.y) * r * g0[j].z, y3 = bf_hi(x.y) + bf_hi(w.y) * r * g0[j].w;
                const float y4 = bf_lo(x.z) + bf_lo(w.z) * r * g1[j].x, y5 = bf_hi(x.z) + bf_hi(w.z) * r * g1[j].y, y6 = bf_lo(x.w) + bf_lo(w.w) * r * g1[j].z, y7 = bf_hi(x.w) + bf_hi(w.w) * r * g1[j].w;
                v2u o; o.x = q8pack(y0, y1, y2, y3, inv); o.y = q8pack(y4, y5, y6, y7, inv); q[64 * j] = o; }
            if (lane == 0) rs8_0[m] = ymx[i] * (1.0f / 127.0f) / sqrtf(s2[i] * (1.0f / DM) + RMS_EPS); } }
    }
}
__device__ __forceinline__ float slope_of(int h) { return exp2f(-8.0f * (float)(h + 1) / (float)NH); }
namespace att {
typedef short bf16x8 __attribute__((ext_vector_type(8)));
typedef short s16x4 __attribute__((ext_vector_type(4)));
typedef float f32x16 __attribute__((ext_vector_type(16)));
typedef unsigned u32x4 __attribute__((ext_vector_type(4)));
enum { MEM = 0, DIL = 1, OWN = 2, SPARSE = 3 };
constexpr float C_L2 = SCALE * 1.4426950408889634f;
constexpr int SHM_V = 16384, SHM_K = 16384;
constexpr int A_V = 0, A_K = 2 * SHM_V, A_WS = A_K + 2 * SHM_K, A_KM = A_WS + NWAVES * 256, A_END = A_KM + MOBA_NB * HD * 4;
constexpr int A_PRE = A_END, A_END2 = A_PRE + 2048;
static_assert(A_END2 <= RING_BYTES, "attention LDS");
#define KSWZ(row, colB) ((row) * 256 + ((colB) ^ (((row) & 7) << 4)))
#define SBAR() __builtin_amdgcn_sched_barrier(0)
__device__ __forceinline__ int crow(int r, int hi) { return (r & 3) + 8 * (r >> 2) + 4 * hi; }
__device__ __forceinline__ unsigned cvtpk(float lo, float hi) { unsigned r; asm volatile("v_cvt_pk_bf16_f32 %0, %1, %2" : "=v"(r) : "v"(lo), "v"(hi)); return r; }
__device__ __forceinline__ int v_st(int k, int c) { const int kk = (k & ~0xC) | ((k & 4) << 1) | ((k & 8) >> 1); return ((kk >> 3) * 4 + (c >> 5)) * 512 + ((kk & 7) * 32 + (c & 31)) * 2; }
__device__ __forceinline__ int v_rd_base(int lane) { return ((lane & 3) << 3) | (((lane >> 2) & 3) << 6) | (((lane >> 4) & 1) << 5) | (((lane >> 5) & 1) << 8); }
constexpr int v_rd_off(int d0, int ks, int half) { return d0 * 512 + ks * 4096 + half * 2048; }
template <int OFF> __device__ __forceinline__ s16x4 tr_read(int vb) { s16x4 r; asm volatile("ds_read_b64_tr_b16 %0, %1 offset:%2" : "=&v"(r) : "v"(vb), "i"(OFF) : "memory"); return r; }
template <int D0> __device__ __forceinline__ void pv_one(f32x16& od, int vb, bf16x8 pa0, bf16x8 pa1, bf16x8 pa2, bf16x8 pa3) {
  const s16x4 l0 = tr_read<v_rd_off(D0, 0, 0)>(vb), h0 = tr_read<v_rd_off(D0, 0, 1)>(vb), l1 = tr_read<v_rd_off(D0, 1, 0)>(vb), h1 = tr_read<v_rd_off(D0, 1, 1)>(vb);
  const s16x4 l2 = tr_read<v_rd_off(D0, 2, 0)>(vb), h2 = tr_read<v_rd_off(D0, 2, 1)>(vb), l3 = tr_read<v_rd_off(D0, 3, 0)>(vb), h3 = tr_read<v_rd_off(D0, 3, 1)>(vb);
  asm volatile("s_waitcnt lgkmcnt(0)" ::: "memory"); SBAR();
#define PKV(L, H) (bf16x8){L[0], L[1], L[2], L[3], H[0], H[1], H[2], H[3]}
  od = __builtin_amdgcn_mfma_f32_32x32x16_bf16(PKV(l0, h0), pa0, od, 0, 0, 0);
  od = __builtin_amdgcn_mfma_f32_32x32x16_bf16(PKV(l1, h1), pa1, od, 0, 0, 0);
  od = __builtin_amdgcn_mfma_f32_32x32x16_bf16(PKV(l2, h2), pa2, od, 0, 0, 0);
  od = __builtin_amdgcn_mfma_f32_32x32x16_bf16(PKV(l3, h3), pa3, od, 0, 0, 0);
#undef PKV
}
__device__ __forceinline__ void store_row_t21(const f32x16 (&o)[4], float rl, bf16* orow, int hi) {
#pragma unroll
  for (int d0 = 0; d0 < 4; ++d0)
#pragma unroll
    for (int k = 0; k < 4; k += 2) {
      unsigned ax = cvtpk(o[d0][4 * k + 0] * rl, o[d0][4 * k + 1] * rl), ay = cvtpk(o[d0][4 * k + 2] * rl, o[d0][4 * k + 3] * rl);
      unsigned bx = cvtpk(o[d0][4 * k + 4] * rl, o[d0][4 * k + 5] * rl), by = cvtpk(o[d0][4 * k + 6] * rl, o[d0][4 * k + 7] * rl);
      { auto r = __builtin_amdgcn_permlane32_swap(ax, bx, false, false); ax = r[0]; bx = r[1]; }
      { auto r = __builtin_amdgcn_permlane32_swap(ay, by, false, false); ay = r[0]; by = r[1]; }
      *(u32x4*)(orow + d0 * 32 + 8 * k + (hi ? 8 : 0)) = (u32x4){ax, ay, bx, by}; }
}
__device__ __forceinline__ void qkt(f32x16& p0, f32x16& p1, const LAS char* Ks, const bf16x8 (&qr)[8], int r32, int hi) {
  p0 = f32x16{}; p1 = f32x16{};
#pragma unroll
  for (int d0 = 0; d0 < 8; ++d0) { const int cb = (d0 * 16 + hi * 8) * 2;
    const bf16x8 b0 = *(const LAS bf16x8*)(Ks + KSWZ(r32, cb));
    const bf16x8 b1 = *(const LAS bf16x8*)(Ks + KSWZ(32 + r32, cb));
    p0 = __builtin_amdgcn_mfma_f32_32x32x16_bf16(b0, qr[d0], p0, 0, 0, 0);
    p1 = __builtin_amdgcn_mfma_f32_32x32x16_bf16(b1, qr[d0], p1, 0, 0, 0); }
}
struct UnitDesc {
    int qrow0, qstride;
    int qcol, kcol, vcol, ocol;
    int qidx0;
    int kidx0, krow0, kstride;
    int t_begin, t_end;
    float cbr;
    int h;
};
template <int MODE>
__device__ __forceinline__ void attn_unit(const UnitDesc& u, const bf16* P, bf16* O, float* lse_out, LAS char* lds) {
  int tid_ = threadIdx.x; asm volatile("" : "+v"(tid_));
  const int tid = tid_, wid = __builtin_amdgcn_readfirstlane(tid >> 6), lane = tid & 63, r32 = lane & 31, hi = lane >> 5;
  LAS char* V_lds = lds + A_V; LAS char* K_lds = lds + A_K;
  const int qi = wid * 32 + r32;
  const LAS int* rows_l = (const LAS int*)(lds + A_KM); const LAS int* dst_l = rows_l + 256;
  const int qtok = (MODE == SPARSE) ? rows_l[qi] : u.qrow0 + qi * u.qstride;
  const int qidx = (MODE == SPARSE) ? qtok : u.qidx0 + qi;
  bf16x8 qr[8];
  { const bf16* Qw = P + (size_t)qtok * LDP + u.qcol + hi * 8;
#pragma unroll
    for (int d0 = 0; d0 < 8; ++d0) qr[d0] = *(const GAS bf16x8*)(Qw + d0 * 16); }
  const float dhi_c = (MODE == DIL) ? (float)(qidx < 128 ? qidx : 128) : 1e30f;
  const int sr = tid >> 4, sc = (tid & 15) * 8, vst0 = v_st(sr, sc), vst1 = v_st(32 + sr, sc);
  const int vb0 = (int)(unsigned)(size_t)V_lds + v_rd_base(lane);
  bf16x8 vs0, vs1, ks0, ks1;
#define SLOAD(t) do { int i0_ = u.kidx0 + 64 * (t) + sr, i1_ = i0_ + 32; if (MODE == DIL) { i0_ = i0_ < 0 ? 0 : i0_; i1_ = i1_ < 0 ? 0 : i1_; } \
    const bf16* r0_ = P + (size_t)(u.krow0 + i0_ * u.kstride) * LDP + sc; const bf16* r1_ = P + (size_t)(u.krow0 + i1_ * u.kstride) * LDP + sc; \
    ks0 = *(const GAS bf16x8*)(r0_ + u.kcol); vs0 = *(const GAS bf16x8*)(r0_ + u.vcol); ks1 = *(const GAS bf16x8*)(r1_ + u.kcol); vs1 = *(const GAS bf16x8*)(r1_ + u.vcol); } while (0)
#define SWRITE(b) do { *(LAS bf16x8*)(V_lds + (b) * SHM_V + vst0) = vs0; *(LAS bf16x8*)(V_lds + (b) * SHM_V + vst1) = vs1; \
    *(LAS bf16x8*)(K_lds + (b) * SHM_K + KSWZ(sr, sc * 2)) = ks0; *(LAS bf16x8*)(K_lds + (b) * SHM_K + KSWZ(32 + sr, sc * 2)) = ks1; } while (0)
  float m_reg = -1e30f, l_reg = 0.f; f32x16 o[4] = {};
  SLOAD(u.t_begin);
  for (int t = u.t_begin; t < u.t_end; ++t) {
    const int b = (t - u.t_begin) & 1;
    SWRITE(b);
    __syncthreads();
    if (t + 1 < u.t_end) SLOAD(t + 1);
    bool active = true; float dhi = dhi_c;
    if constexpr (MODE == DIL) { const int tlo = wid >> 1; active = (t >= tlo) && (t <= tlo + 2); }
    if constexpr (MODE == OWN) active = (t - u.t_begin) <= (wid >> 1);
    if (active) {
      f32x16 p0, p1; qkt(p0, p1, K_lds + b * SHM_K, qr, r32, hi);
      if constexpr (MODE == SPARSE) {
        const float bf = (float)(qidx - u.kidx0 - 64 * t - 4 * hi), ncb = -u.cbr;
#pragma unroll
        for (int r = 0; r < 16; ++r) { const float d0 = bf - (float)((r & 3) + 8 * (r >> 2)); p0[r] = fmaf(ncb, d0, p0[r]); p1[r] = fmaf(ncb, d0 - 32.f, p1[r]); }
      } else if constexpr (MODE != MEM) {
        const float bf = (float)(qidx - u.kidx0 - 64 * t - 4 * hi), ncb = -u.cbr;
#pragma unroll
        for (int r = 0; r < 16; ++r) { const float d0 = bf - (float)((r & 3) + 8 * (r >> 2)), d1 = d0 - 32.f;
          p0[r] = (d0 >= 0.f && d0 <= dhi) ? fmaf(ncb, d0, p0[r]) : -1e30f;
          p1[r] = (d1 >= 0.f && d1 <= dhi) ? fmaf(ncb, d1, p1[r]) : -1e30f; }
      }
      float pmax = p0[0];
#pragma unroll
      for (int r = 1; r < 16; ++r) pmax = fmaxf(pmax, p0[r]);
#pragma unroll
      for (int r = 0; r < 16; ++r) pmax = fmaxf(pmax, p1[r]);
      { auto rr = __builtin_amdgcn_permlane32_swap(__float_as_uint(pmax), __float_as_uint(pmax), false, false); pmax = fmaxf(__uint_as_float(rr[0]), __uint_as_float(rr[1])); }
      const float mn = fmaxf(m_reg, pmax), alpha = __builtin_amdgcn_exp2f((m_reg - mn) * C_L2); m_reg = mn;
      const float mnC = -mn * C_L2;
#pragma unroll
      for (int r = 0; r < 16; ++r) { p0[r] = __builtin_amdgcn_exp2f(fmaf(p0[r], C_L2, mnC)); p1[r] = __builtin_amdgcn_exp2f(fmaf(p1[r], C_L2, mnC)); }
      float ps = 0.f;
#pragma unroll
      for (int r = 0; r < 16; ++r) ps += p0[r];
#pragma unroll
      for (int r = 0; r < 16; ++r) ps += p1[r];
      { auto rr = __builtin_amdgcn_permlane32_swap(__float_as_uint(ps), __float_as_uint(ps), false, false); ps = __uint_as_float(rr[0]) + __uint_as_float(rr[1]); }
      l_reg = l_reg * alpha + ps;
      bf16x8 pa0, pa1, pa2, pa3;
#define PK4(Pv, BASE, OUT) do { unsigned a0 = cvtpk(Pv[BASE + 0], Pv[BASE + 1]), a1 = cvtpk(Pv[BASE + 2], Pv[BASE + 3]);   \
    unsigned b0 = cvtpk(Pv[BASE + 4], Pv[BASE + 5]), b1 = cvtpk(Pv[BASE + 6], Pv[BASE + 7]);                              \
    auto r0 = __builtin_amdgcn_permlane32_swap(a0, b0, false, false); auto r1 = __builtin_amdgcn_permlane32_swap(a1, b1, false, false); \
    u32x4 w = {r0[0], r1[0], r0[1], r1[1]}; OUT = *reinterpret_cast<bf16x8*>(&w); } while (0)
      PK4(p0, 0, pa0); PK4(p0, 8, pa1); PK4(p1, 0, pa2); PK4(p1, 8, pa3);
#undef PK4
      if (__any(alpha < 1.f)) {
#pragma unroll
        for (int d = 0; d < 4; ++d) o[d] *= alpha; }
      const int vb = vb0 + b * SHM_V;
      pv_one<0>(o[0], vb, pa0, pa1, pa2, pa3); pv_one<1>(o[1], vb, pa0, pa1, pa2, pa3); pv_one<2>(o[2], vb, pa0, pa1, pa2, pa3); pv_one<3>(o[3], vb, pa0, pa1, pa2, pa3);
    }
  }
#undef SLOAD
#undef SWRITE
  { long ob;
    if constexpr (MODE == SPARSE) ob = (long)dst_l[qi] * HD;
    else if constexpr (MODE == OWN) ob = ((long)(qtok * NH + u.h) * 4 + 3) * HD;
    else ob = (long)qtok * DM + u.ocol;
    if (MODE != SPARSE || ob >= 0) store_row_t21(o, 1.0f / l_reg, O + ob, hi); }
  if (hi == 0) { const float lv = m_reg * SCALE + __logf(l_reg);
    if constexpr (MODE == DIL) lse_out[(size_t)qtok * NH + u.h] = lv;
    if constexpr (MODE == OWN) lse_out[((size_t)qtok * NH + u.h) * 4 + 3] = lv;
    if constexpr (MODE == SPARSE) { const int dd = dst_l[qi]; if (dd >= 0) lse_out[dd] = lv; } }
  asm volatile("s_waitcnt lgkmcnt(0)" ::: "memory");
  __syncthreads();
}
constexpr int B_V = 0, B_K = 65536, B_WS = RING_BYTES + 4096, B_PRE = RING_BYTES + 8192;
template <int BMODE>
__device__ __forceinline__ void block_unit(int h, int n, int g0, int g1, int cntv, const int* lst, const unsigned* selm_h, const bf16* P, bf16* O, float* lse_out, LAS char* lds, float cbr) {
  int tid_ = threadIdx.x; asm volatile("" : "+v"(tid_));
  const int tid = tid_, wid = __builtin_amdgcn_readfirstlane(tid >> 6), lane = tid & 63, r32 = lane & 31, hi = lane >> 5;
  LAS char* V_lds = lds + B_V; LAS char* K_lds = lds + B_K;
  const int krow0 = BMODE == 0 ? n * MOBA_BLK : SEQ, kcol = BMODE == 0 ? KCOL + h * HD : KMCOL + h * HD, vcol = BMODE == 0 ? VCOL + h * HD : VMCOL + h * HD, qcol = BMODE == 0 ? QCOL + h * HD : QMCOL + h * HD;
  { const int sr = tid >> 4, sc = (tid & 15) * 8; bf16x8 kq[4][2], vq[4][2];
#pragma unroll
    for (int t = 0; t < 4; ++t)
#pragma unroll
      for (int q = 0; q < 2; ++q) { const bf16* rp = P + (size_t)(krow0 + 64 * t + 32 * q + sr) * LDP + sc; kq[t][q] = *(const GAS bf16x8*)(rp + kcol); vq[t][q] = *(const GAS bf16x8*)(rp + vcol); }
#pragma unroll
    for (int t = 0; t < 4; ++t)
#pragma unroll
      for (int q = 0; q < 2; ++q) { *(LAS bf16x8*)(K_lds + t * SHM_K + KSWZ(32 * q + sr, sc * 2)) = kq[t][q]; *(LAS bf16x8*)(V_lds + t * SHM_V + v_st(32 * q + sr, sc)) = vq[t][q]; } }
  __syncthreads();
  const int vb0 = (int)(unsigned)(size_t)V_lds + v_rd_base(lane);
  if (wid & 4) __builtin_amdgcn_s_sleep(16);
#define BU_ROWINFO(gg, TOK, DST) do { if constexpr (BMODE == 1) { TOK = 32 * (gg) + r32; DST = 0; } \
    else { if ((gg) < 8) { TOK = n * MOBA_BLK + 32 * (gg) + r32; DST = (TOK * NH + h) * 4 + 3; } \
           else { const int idx_ = 32 * ((gg) - 8) + r32; const bool valid_ = idx_ < cntv; TOK = lst[valid_ ? idx_ : 0]; const unsigned sm_ = selm_h[TOK]; DST = valid_ ? (TOK * NH + h) * 4 + __popc(sm_ & ((1u << n) - 1u)) : -1; } } } while (0)
#define BU_QLOAD(QR, TOK) do { const bf16* Qw_ = P + (size_t)(TOK) * LDP + qcol + hi * 8; _Pragma("unroll") for (int d0_ = 0; d0_ < 8; ++d0_) QR[d0_] = *(const GAS bf16x8*)(Qw_ + d0_ * 16); } while (0)
  int g = g0 + wid;
  if (g < g1) {
  int qtok, dst;
  BU_ROWINFO(g, qtok, dst);
  for (;;) {
    const int gn = g + NWAVES;
    bf16x8 qr[8]; BU_QLOAD(qr, qtok);
    int tok1 = 0, dst1 = -1;
    if (gn < g1) BU_ROWINFO(gn, tok1, dst1);
    asm volatile("" ::: "memory");
    const bool own = BMODE == 0 && g < 8;
    float m_reg = -1e30f, l_reg = 0.f; f32x16 o[4] = {};
    const int tmax = own ? (g >> 1) : 3;
    auto softmax_tile = [&](const int t, f32x16& p0, f32x16& p1, bf16x8& pa0, bf16x8& pa1, bf16x8& pa2, bf16x8& pa3) -> float {
      if constexpr (BMODE == 0) {
        const float bf = (float)(qtok - n * MOBA_BLK - 64 * t - 4 * hi), ncb = -cbr;
        if (own) {
#pragma unroll
          for (int r = 0; r < 16; ++r) { const float d0 = bf - (float)((r & 3) + 8 * (r >> 2)), d1 = d0 - 32.f;
            p0[r] = d0 >= 0.f ? fmaf(ncb, d0, p0[r]) : -1e30f; p1[r] = d1 >= 0.f ? fmaf(ncb, d1, p1[r]) : -1e30f; }
        } else {
#pragma unroll
          for (int r = 0; r < 16; ++r) { const float d0 = bf - (float)((r & 3) + 8 * (r >> 2)); p0[r] = fmaf(ncb, d0, p0[r]); p1[r] = fmaf(ncb, d0 - 32.f, p1[r]); }
        }
      }
      float pmax = p0[0];
#pragma unroll
      for (int r = 1; r < 16; ++r) pmax = fmaxf(pmax, p0[r]);
#pragma unroll
      for (int r = 0; r < 16; ++r) pmax = fmaxf(pmax, p1[r]);
      { auto rr = __builtin_amdgcn_permlane32_swap(__float_as_uint(pmax), __float_as_uint(pmax), false, false); pmax = fmaxf(__uint_as_float(rr[0]), __uint_as_float(rr[1])); }
      const float mn = fmaxf(m_reg, pmax), alpha = __builtin_amdgcn_exp2f((m_reg - mn) * C_L2); m_reg = mn;
      const float mnC = -mn * C_L2;
#pragma unroll
      for (int r = 0; r < 16; ++r) { p0[r] = __builtin_amdgcn_exp2f(fmaf(p0[r], C_L2, mnC)); p1[r] = __builtin_amdgcn_exp2f(fmaf(p1[r], C_L2, mnC)); }
      float ps = 0.f;
#pragma unroll
      for (int r = 0; r < 16; ++r) ps += p0[r];
#pragma unroll
      for (int r = 0; r < 16; ++r) ps += p1[r];
      { auto rr = __builtin_amdgcn_permlane32_swap(__float_as_uint(ps), __float_as_uint(ps), false, false); ps = __uint_as_float(rr[0]) + __uint_as_float(rr[1]); }
      l_reg = l_reg * alpha + ps;
#define PK4(Pv, BASE, OUT) do { unsigned a0 = cvtpk(Pv[BASE + 0], Pv[BASE + 1]), a1 = cvtpk(Pv[BASE + 2], Pv[BASE + 3]);   \
    unsigned b0 = cvtpk(Pv[BASE + 4], Pv[BASE + 5]), b1 = cvtpk(Pv[BASE + 6], Pv[BASE + 7]);                              \
    auto r0 = __builtin_amdgcn_permlane32_swap(a0, b0, false, false); auto r1 = __builtin_amdgcn_permlane32_swap(a1, b1, false, false); \
    u32x4 w = {r0[0], r1[0], r0[1], r1[1]}; OUT = *reinterpret_cast<bf16x8*>(&w); } while (0)
      PK4(p0, 0, pa0); PK4(p0, 8, pa1); PK4(p1, 0, pa2); PK4(p1, 8, pa3);
#undef PK4
      return alpha; };
    bf16x8 qa0, qa1, qa2, qa3;
    { f32x16 p0, p1; qkt(p0, p1, K_lds, qr, r32, hi); (void)softmax_tile(0, p0, p1, qa0, qa1, qa2, qa3); }
    for (int t = 1; t <= tmax; ++t) {
      f32x16 p0, p1; qkt(p0, p1, K_lds + t * SHM_K, qr, r32, hi);
      { const int vb = vb0 + (t - 1) * SHM_V; pv_one<0>(o[0], vb, qa0, qa1, qa2, qa3); pv_one<1>(o[1], vb, qa0, qa1, qa2, qa3); pv_one<2>(o[2], vb, qa0, qa1, qa2, qa3); pv_one<3>(o[3], vb, qa0, qa1, qa2, qa3); }
      bf16x8 pa0, pa1, pa2, pa3; const float alpha = softmax_tile(t, p0, p1, pa0, pa1, pa2, pa3);
      if (__any(alpha < 1.f)) {
#pragma unroll
        for (int d = 0; d < 4; ++d) o[d] *= alpha; }
      qa0 = pa0; qa1 = pa1; qa2 = pa2; qa3 = pa3;
    }
    { const int vb = vb0 + tmax * SHM_V; pv_one<0>(o[0], vb, qa0, qa1, qa2, qa3); pv_one<1>(o[1], vb, qa0, qa1, qa2, qa3); pv_one<2>(o[2], vb, qa0, qa1, qa2, qa3); pv_one<3>(o[3], vb, qa0, qa1, qa2, qa3); }
    { const long ob = BMODE == 1 ? (long)qtok * DM + SELF_W + h * HD : (long)dst * HD;
      if (BMODE == 1 || dst >= 0) store_row_t21(o, 1.0f / l_reg, O + ob, hi); }
    if constexpr (BMODE == 0) { if (hi == 0 && dst >= 0) lse_out[dst] = m_reg * SCALE + __logf(l_reg); }
    if (gn >= g1) break;
    qtok = tok1; dst = dst1; g = gn;
  }
  }
#undef BU_ROWINFO
#undef BU_QLOAD
  __syncthreads();
}
__device__ __forceinline__ void gate_unit(int h, int qb, const bf16* P, const float* kmean, unsigned* selmask_out, float* plse, unsigned* cnt, int* list, LAS char* lds) {
  int tid_ = threadIdx.x; asm volatile("" : "+v"(tid_));
  const int tid = tid_, wid = __builtin_amdgcn_readfirstlane(tid >> 6), lane = tid & 63, r32 = lane & 31, hi = lane >> 5;
  const int srow = qb * MOBA_BLK + wid * 32 + r32;
  unsigned selmask = 0u;
  if (qb > 0) {
    LAS float* km = (LAS float*)(lds + A_KM);
    for (int i = tid; i < qb * HD; i += NWAVES * 64) km[i] = kmean[(size_t)h * MOBA_NB * HD + i];
    bf16x8 qr[8];
    { const bf16* Qw = P + (size_t)srow * LDP + QCOL + h * HD + hi * 8;
#pragma unroll
      for (int d0 = 0; d0 < 8; ++d0) qr[d0] = *(const GAS bf16x8*)(Qw + d0 * 16); }
    __syncthreads();
    float qf[64];
#pragma unroll
    for (int d0 = 0; d0 < 8; ++d0)
#pragma unroll
      for (int j = 0; j < 8; ++j) qf[d0 * 8 + j] = __uint_as_float(((unsigned)(unsigned short)qr[d0][j]) << 16);
    float b1 = -INFINITY, b2 = -INFINITY, b3 = -INFINITY; int i1 = -1, i2 = -1, i3 = -1;
    for (int n = 0; n < qb; ++n) {
      const LAS float* kr = km + n * HD + hi * 8; float a = 0.f;
#pragma unroll
      for (int d0 = 0; d0 < 8; ++d0) { const f32x4 k0 = *(const LAS f32x4*)(kr + d0 * 16), k1 = *(const LAS f32x4*)(kr + d0 * 16 + 4);
        a += qf[d0 * 8 + 0] * k0.x + qf[d0 * 8 + 1] * k0.y + qf[d0 * 8 + 2] * k0.z + qf[d0 * 8 + 3] * k0.w + qf[d0 * 8 + 4] * k1.x + qf[d0 * 8 + 5] * k1.y + qf[d0 * 8 + 6] * k1.z + qf[d0 * 8 + 7] * k1.w; }
      a += __shfl_xor(a, 32);
      if (a > b1) { b3 = b2; i3 = i2; b2 = b1; i2 = i1; b1 = a; i1 = n; } else if (a > b2) { b3 = b2; i3 = i2; b2 = a; i2 = n; } else if (a > b3) { b3 = a; i3 = n; }
    }
    selmask = (i1 >= 0 ? 1u << i1 : 0u) | (i2 >= 0 ? 1u << i2 : 0u) | (i3 >= 0 ? 1u << i3 : 0u);
  }
  LAS int* sm_l = (LAS int*)(lds + A_V); LAS int* cw = sm_l + 256; LAS int* cwpre = cw + 256; LAS int* base_l = cwpre + 256; LAS int* posl = base_l + 32;
  if (hi == 0) { selmask_out[(size_t)h * SEQ + srow] = selmask; const int ns = __popc(selmask); sm_l[wid * 32 + r32] = (int)selmask;
    float* pl = plse + ((size_t)srow * NH + h) * 4;
    if (ns < 1) pl[0] = -INFINITY; if (ns < 2) pl[1] = -INFINITY; if (ns < 3) pl[2] = -INFINITY; }
  __syncthreads();
  if (tid < 256) { const int n = tid & 31, w = tid >> 5; int c = 0;
    for (int r = 0; r < 32; ++r) { const unsigned sm = (unsigned)sm_l[w * 32 + r]; if ((sm >> n) & 1u) { posl[(w * 32 + r) * 4 + __popc(sm & ((1u << n) - 1u))] = c; ++c; } }
    cw[n * 8 + w] = c; }
  __syncthreads();
  if (tid < 32) { int tot = 0;
#pragma unroll
    for (int w = 0; w < 8; ++w) { cwpre[tid * 8 + w] = tot; tot += cw[tid * 8 + w]; }
    base_l[tid] = tot > 0 ? (int)__hip_atomic_fetch_add(cnt + h * MOBA_NB + tid, (unsigned)tot, __ATOMIC_RELAXED, __HIP_MEMORY_SCOPE_AGENT) : 0; }
  __syncthreads();
  if (hi == 0) { unsigned sm = selmask; const int row = wid * 32 + r32;
    while (sm) { const int n = __ffs((int)sm) - 1; const int slot = __popc(selmask & ((1u << n) - 1u));
      list[(size_t)(h * MOBA_NB + n) * SEQ + base_l[n] + cwpre[n * 8 + wid] + posl[row * 4 + slot]] = srow; sm &= sm - 1u; } }
  __syncthreads();
}
#undef KSWZ
#undef SBAR
}

struct Args { const float* in[10]; float* out; unsigned char* ws; };
__global__ void __launch_bounds__(NWAVES * 64, 2) trunk_fwd(Args args) {
    extern __shared__ __attribute__((aligned(16))) unsigned char lds_raw[];
    Ctx F;
    F.lds = (LAS unsigned char*)lds_raw;
    volatile LAS unsigned* MISC = (volatile LAS unsigned*)(F.lds + MISC_OFF);
    F.tid = threadIdx.x; F.lane = F.tid & 63; F.wave = __builtin_amdgcn_readfirstlane(F.tid >> 6);
    F.G = gridDim.x; { const int bx = blockIdx.x; F.vcu = (F.G % 8 == 0) ? (bx % 8) * (F.G / 8) + bx / 8 : bx; }
    unsigned char* ws = args.ws;
    unsigned* ctl = (unsigned*)(ws + WS_CTL);
    for (int u = F.tid; u < (LDS_BYTES - LDSCTL_OFF) / 4; u += NWAVES * 64) ((LAS unsigned*)(F.lds + LDSCTL_OFF))[u] = 0u;
    __syncthreads();
    XcdBarrier bar = xcd_barrier_post(ctl + CW_BAR, MISC + 8);
#define GRID_BAR() xcd_barrier(bar)

    const float* x_in = args.in[0]; const float* mem = args.in[1]; const float* g_pre = args.in[2]; const float* g_post = args.in[3]; const float* g_mem = args.in[4];
    const float* w_ffn_in = args.in[5]; const float* w_ffn_out = args.in[6]; const float* w_in = args.in[7]; const float* w_mem_kv = args.in[8]; const float* w_out = args.in[9];
    float* X = args.out;
    unsigned char* Cat8 = ws + WS_A; float* cat_rs = (float*)(ws + WS_RSTD + 128 * 1024);     bf16* Hb = (bf16*)(ws + WS_H); unsigned char* H8 = ws + WS_F + 32 * MiB; float* rs8 = (float*)(ws + WS_RSTD + 64 * 1024);     bf16* Ab = (bf16*)(ws + WS_A); bf16* Fb = (bf16*)(ws + WS_F); float* rstd = (float*)(ws + WS_RSTD); bf16* Pb = (bf16*)(ws + WS_P); bf16* Cat = (bf16*)(ws + WS_CAT);
    float* kmean = (float*)(ws + WS_KMEAN);
#define PHASE_BEGIN() int tid_ = threadIdx.x; asm volatile("" : "+v"(tid_)); int bx_ = blockIdx.x, G_ = gridDim.x; asm volatile("" : "+s"(bx_), "+s"(G_)); \
    const int lane = tid_ & 63, wave = __builtin_amdgcn_readfirstlane(tid_ >> 6), vcu = (G_ % 8 == 0) ? (bx_ % 8) * (G_ / 8) + bx_ / 8 : bx_, gw = vcu * NWAVES + wave, NGW = G_ * NWAVES; (void)lane; (void)gw; (void)NGW

    constexpr int I_IN = (DM / 64) * (2 * DFF / 32), I_OUT = (DFF / 64) * (DM / 32), I_QKV = (DM / 64) * (IN_W / 32), I_MKV = (DM / 64) * (KVW / 32), I_O = (DM / 64) * (DM / 32);
    constexpr int I_LAYER = 2 * I_IN + 2 * I_OUT + I_QKV + I_MKV + I_O;
#ifndef TAIL_FILL
#define TAIL_FILL 1
#endif
#ifndef TAIL_FRAC
#define TAIL_FRAC 256
#endif
    constexpr int P0_LAYERS = TAIL_FILL ? 1 : DEPTH;
#define CONVERT_ITEM(l_, r_) do { const int cl_ = (l_); int cr_ = (r_); unsigned char* cw_ = ws + WS_W + (size_t)cl_ * LW; \
        if (cr_ < 2 * I_IN) { } \
        else if ((cr_ -= 2 * I_IN) < 2 * I_OUT) { const int half = cr_ / I_OUT; cr_ %= I_OUT; const int nblk = DM / 32, k0 = 64 * (cr_ / nblk), n0 = 32 * (cr_ % nblk); \
            p0_transpose_item(w_ffn_out + (size_t)(cl_ * 2 + half) * DFF * DM, DFF, DM, (bf16*)(cw_ + LW_OUT + (size_t)half * 22 * MiB), k0, n0, n0, scr, lane, nullptr); } \
        else if ((cr_ -= 2 * I_OUT) < I_QKV) { const int nblk = IN_W / 32, k0 = 64 * (cr_ / nblk), n0 = 32 * (cr_ % nblk); \
            p0_transpose_item(w_in + (size_t)cl_ * DM * IN_W, DM, IN_W, (bf16*)(cw_ + LW_QKV), k0, n0, n0, scr, lane, g_pre + (size_t)(cl_ * 3 + 1) * DM); } \
        else if ((cr_ -= I_QKV) < I_MKV) { const int nblk = KVW / 32, k0 = 64 * (cr_ / nblk), n0 = 32 * (cr_ % nblk); \
            p0_transpose_item(w_mem_kv + (size_t)cl_ * DM * KVW, DM, KVW, (bf16*)(cw_ + LW_QKV), k0, n0, IN_W + n0, scr, lane, g_mem + (size_t)cl_ * DM); } \
        else { cr_ -= I_MKV; const int nblk = DM / 32, k0 = 64 * (cr_ / nblk), n0 = 32 * (cr_ % nblk); \
            p0_transpose_item(w_out + (size_t)cl_ * DM * DM, DM, DM, (bf16*)(cw_ + LW_O), k0, n0, n0, scr, lane, nullptr); } } while (0)
    constexpr int C_SPLIT = 2816;
    constexpr int N_STRIP = 2 * DFF / 32, S_SPLIT = C_SPLIT / 32;
#define CONVERT_STRIP(l_, half_, s_) do { const int cl_ = (l_), ch_ = (half_), n0 = 32 * (s_); unsigned char* cw_ = ws + WS_W + (size_t)cl_ * LW + LW_IN + (size_t)ch_ * 44 * MiB; \
        const int j = n0 < DFF ? n0 : n0 - DFF; const int drow = 256 * (j / 128) + (n0 < DFF ? 0 : 128) + (j % 128); \
        strip_convert8(w_ffn_in + (size_t)(cl_ * 2 + ch_) * DM * 2 * DFF, 2 * DFF, g_pre + (size_t)(cl_ * 3 + 2 * ch_) * DM, cw_, (float*)(cw_ + 32 * MiB), n0, drow, scr, (LAS float*)(F.lds + CMAX_OFF), wave, lane, n0 < DFF ? 1.4426950408889634f : 0.6931471805599453f); } while (0)
    constexpr int NQ_STRIP = IN_W / 32, NQ_ALL = LDP / 32;
#define CONVERT_QSTRIP(l_, s_) do { const int cl_ = (l_), cs_ = (s_); unsigned char* cw_ = ws + WS_W + (size_t)cl_ * LW + LW_QKV; \
        if (cs_ < NQ_STRIP) strip_convert8(w_in + (size_t)cl_ * DM * IN_W, IN_W, g_pre + (size_t)(cl_ * 3 + 1) * DM, cw_, (float*)(cw_ + 16 * MiB), 32 * cs_, 32 * cs_, scr, (LAS float*)(F.lds + CMAX_OFF), wave, lane); \
        else strip_convert8(w_mem_kv + (size_t)cl_ * DM * KVW, KVW, g_mem + (size_t)cl_ * DM, cw_, (float*)(cw_ + 16 * MiB), 32 * (cs_ - NQ_STRIP), 32 * cs_, scr, (LAS float*)(F.lds + CMAX_OFF), wave, lane); } while (0)
#define CONVERT_OSTRIP(l_, s_) do { const int cl_ = (l_); unsigned char* cw_ = ws + WS_W + (size_t)cl_ * LW + LW_O; \
        strip_convert8(w_out + (size_t)cl_ * DM * DM, DM, nullptr, cw_, (float*)(cw_ + 6 * MiB), 32 * (s_), 32 * (s_), scr, (LAS float*)(F.lds + CMAX_OFF), wave, lane); } while (0)
#define QSTRIP_RANGE(lay_) do { for (int st = bx_ - fi_; st < NQ_ALL + DM / 32; st += G_ - fi_) { if (st < NQ_ALL) CONVERT_QSTRIP((lay_), st); else CONVERT_OSTRIP((lay_), st - NQ_ALL); } } while (0)
#define QSTRIP_RANGE_OLD(lay_) do { for (int st = bx_ - fi_; st < NQ_ALL; st += G_ - fi_) CONVERT_QSTRIP((lay_), st); } while (0)
#define STRIP_RANGE(lay_, half_, a_, b_) do { for (int st = (a_) + (bx_ - fi_); st < (b_); st += G_ - fi_) CONVERT_STRIP((lay_), (half_), st); } while (0)
#define CONV_RANGE(lay_, a_, b_) do { for (int it = (a_) + w0_; it < (b_); it += nw_) CONVERT_ITEM((lay_), it); } while (0)
#ifndef TAIL_SHARE
#define TAIL_SHARE 197
#endif
#define TAIL_STRIP(l_, tail_, i_) do { const int ti_ = (i_); \
        if ((tail_) == 0) { if (ti_ < NQ_ALL) CONVERT_QSTRIP((l_), ti_); else CONVERT_OSTRIP((l_), ti_ - NQ_ALL); } \
        else if ((tail_) == 1) { if (ti_ < N_STRIP) CONVERT_STRIP((l_), 1, ti_); else CONVERT_STRIP((l_) + 1, 0, ti_ - N_STRIP); } \
        else CONVERT_STRIP((l_) + 1, 0, S_SPLIT + ti_); } while (0)
#define TAIL_CONVERT(l_, tail_, first_idle_) do { if (TAIL_FILL) { PHASE_BEGIN(); const int fi_ = (first_idle_); const bool conv_ = bx_ >= fi_; \
        const int cwi_ = conv_ ? bx_ - fi_ : bx_, cwn_ = conv_ ? G_ - fi_ : fi_; \
        LAS float* scr = (LAS float*)(F.lds + RING_OFF + wave * 16384); const int nw_ = cwn_ * NWAVES, w0_ = cwi_ * NWAVES + wave; \
        const bool nxt_ = (l_) + 1 < DEPTH; \
        const int nS_ = (tail_) == 0 ? NQ_ALL + DM / 32 : ((tail_) == 1 ? N_STRIP + (nxt_ ? S_SPLIT : 0) : (nxt_ ? N_STRIP - S_SPLIT : 0)); \
        const int nI_ = (tail_) == 1 ? 0 : I_OUT, i0_ = 2 * I_IN + ((tail_) == 2 ? I_OUT : 0); \
        const int spS_ = nS_ * TAIL_SHARE / 256, spI_ = nI_ * TAIL_SHARE / 256; \
        const int ia_ = conv_ ? 0 : spI_, ib_ = conv_ ? spI_ : nI_, sa_ = conv_ ? 0 : spS_, sb_ = conv_ ? spS_ : nS_; \
        for (int it = i0_ + ia_ + w0_; it < i0_ + ib_; it += nw_) CONVERT_ITEM((l_), it); \
        for (int st = sa_ + cwi_; st < sb_; st += cwn_) TAIL_STRIP((l_), (tail_), st); } } while (0)
    {
        PHASE_BEGIN();
        LAS float* scr = (LAS float*)(F.lds + RING_OFF + wave * 16384);
        for (int st = vcu; st < N_STRIP; st += G_) CONVERT_STRIP(0, 0, st);
        for (int m = gw; m < MROWS; m += NGW) cast_row(m < SEQ ? x_in + (size_t)m * DM : mem + (size_t)(m - SEQ) * DM, Hb + (size_t)m * DM, rstd + m, lane, H8 + (size_t)m * DM, rs8 + m);
    }
    GRID_BAR();

#define QUANT_ROW(s_) do { { const v4u w_ = *((const GAS v4u*)(Cat + (size_t)(s_) * DM) + 192 + lane); \
            ov[3][0] = bf_lo(w_.x); ov[3][1] = bf_hi(w_.x); ov[3][2] = bf_lo(w_.y); ov[3][3] = bf_hi(w_.y); ov[3][4] = bf_lo(w_.z); ov[3][5] = bf_hi(w_.z); ov[3][6] = bf_lo(w_.w); ov[3][7] = bf_hi(w_.w); } \
        float mx_ = 0.f; \
        _Pragma("unroll") for (int a_ = 0; a_ < 4; ++a_) _Pragma("unroll") for (int e_ = 0; e_ < 8; ++e_) mx_ = fmaxf(mx_, fabsf(ov[a_][e_])); \
        mx_ = wave_max(mx_); const float inv_ = mx_ > 0.f ? 127.0f / mx_ : 0.f; \
        _Pragma("unroll") for (int a_ = 0; a_ < 4; ++a_) { v2u o_; o_.x = q8pack(ov[a_][0], ov[a_][1], ov[a_][2], ov[a_][3], inv_); o_.y = q8pack(ov[a_][4], ov[a_][5], ov[a_][6], ov[a_][7], inv_); \
            *((GAS v2u*)(Cat8 + (size_t)(s_) * DM) + lane + 64 * a_) = o_; } \
        if (lane == 0) cat_rs[(s_)] = mx_ * (1.0f / 127.0f); } while (0)
#ifndef DBG_MAXSUB
#define DBG_MAXSUB (3 * DEPTH)
#endif
#ifndef FUSE_THIN
#define FUSE_THIN 1
#endif
    const bool fuse = FUSE_THIN && gridDim.x == (SEQ / 256) * (DM / 256);
#define FUSED_EPI() pg8::EpiNormRes E{Hb, g_post + (size_t)(l * 3 + part) * DM, part == 1 ? 1.0f : 0.5f, (sub + 1 == 3 * DEPTH) ? X : nullptr, rstd, (unsigned*)(ws + WS_SLOT1), (unsigned*)(ws + WS_SLOT2), \
        ctl + CW_X1, ctl + CW_X2, 32u * (unsigned)(sub + 1), ctl + 2, DM, 1.0f / DM, RMS_EPS}
    for (int sub = 0; sub < DBG_MAXSUB; ++sub) {
        const int l = sub / 3, part = sub % 3;
        unsigned char* wl = ws + WS_W + (size_t)l * LW;
        if (part != 1) {
            const int half = part >> 1;
            {
                int cc = blockIdx.x, GG = gridDim.x; asm volatile("" : "+s"(cc), "+s"(GG));
                pg8::Gemm g{(const bf16*)H8, (const bf16*)(wl + LW_IN + (size_t)half * 44 * MiB), SEQ, 2 * DFF, DM / 2}; pg8::XOrder S; S.init(SEQ, 2 * DFF, GG, cc, 0);
                pg8::EpiSwiGLU8 E{Ab, DFF, rs8, (const float*)(wl + LW_IN + (size_t)half * 44 * MiB + 32 * MiB), (LAS float*)(F.lds + RSTAB_OFF), (LAS float*)(F.lds + CSTAB_OFF)};
                pg8::gemm_phase<pg8::EpiSwiGLU8, pg8::XOrder, true, true, true>(F.lds + RING_OFF, g, S, E);
            }
            TAIL_CONVERT(l, part, (SEQ / 256) * (2 * DFF / 256) % 256);
            GRID_BAR();
            {
                int cc = blockIdx.x, GG = gridDim.x; asm volatile("" : "+s"(cc), "+s"(GG));
                pg8::Gemm g{Ab, (const bf16*)(wl + LW_OUT + (size_t)half * 22 * MiB), SEQ, DM, DFF}; pg8::XOrder S; S.init(SEQ, DM, GG, cc, 0);
                if (fuse) { FUSED_EPI(); pg8::gemm_phase<pg8::EpiNormRes, pg8::XOrder, false, true>(F.lds + RING_OFF, g, S, E); }
                else { pg8::EpiBf16 E{Fb, DM, nullptr, (LAS float*)(F.lds + RSTAB_OFF)}; pg8::gemm_phase<pg8::EpiBf16, pg8::XOrder, true, true>(F.lds + RING_OFF, g, S, E); }
            }
        } else {
            {
                int cc = blockIdx.x, GG = gridDim.x; asm volatile("" : "+s"(cc), "+s"(GG));
                pg8::Gemm g{(const bf16*)H8, (const bf16*)(wl + LW_QKV), SEQ, IN_W, DM / 2}; pg8::XOrder S; S.init(SEQ, IN_W, GG, cc, KVW / 256);
                pg8::EpiBf16I8 E{Pb, LDP, rs8, (const float*)(wl + LW_QKV + 16 * MiB), (LAS float*)(F.lds + RSTAB_OFF), (LAS float*)(F.lds + CSTAB_OFF)};
                pg8::gemm_phase<pg8::EpiBf16I8, pg8::XOrder, true, true, true>(F.lds + RING_OFF, g, S, E);
            }
            TAIL_CONVERT(l, 1, ((SEQ / 256) * (IN_W / 256) + KVW / 256) % 256);
            GRID_BAR();
            float* lse = (float*)(ws + WS_LSE);
            if ((l & 1) == 0) {
                {
                    PHASE_BEGIN();
                    LAS float* red = (LAS float*)(F.lds + RING_OFF);
                    for (int it = bx_; it < NH * MOBA_NB; it += G_) { const int h = it / MOBA_NB, n = it % MOBA_NB;
                        const GAS unsigned* kp = (const GAS unsigned*)(Pb + (size_t)(n * MOBA_BLK + wave * 32) * LDP + KCOL + h * HD) + lane; unsigned wv[32];
#pragma unroll
                        for (int r = 0; r < 32; ++r) wv[r] = kp[(size_t)r * (LDP / 2)];
                        float a0 = 0.f, a1 = 0.f;
#pragma unroll
                        for (int r = 0; r < 32; ++r) { a0 += bf_lo(wv[r]); a1 += bf_hi(wv[r]); }
                        red[wave * HD + 2 * lane] = a0; red[wave * HD + 2 * lane + 1] = a1;
                        __syncthreads();
                        if (tid_ < HD) { float sacc = 0.f;
#pragma unroll
                            for (int w = 0; w < NWAVES; ++w) sacc += red[w * HD + tid_];
                            kmean[(size_t)it * HD + tid_] = sacc * (1.0f / MOBA_BLK); }
                        __syncthreads(); }
                }
                GRID_BAR();
                unsigned* mcnt = ctl + CW_CNT + (l >> 1) * (NH * MOBA_NB); unsigned* selm = (unsigned*)(ws + WS_SEL); float* plse = (float*)(ws + WS_PLSE); int* mlist = (int*)(ws + WS_LIST); bf16* part = (bf16*)(ws + WS_PART);
                {
                    int bx = blockIdx.x, GG = gridDim.x; asm volatile("" : "+s"(bx), "+s"(GG));
                    for (int i = 0; i * GG < NH * MOBA_NB; ++i) { const int u = (i & 1) ? (i + 1) * GG - 1 - bx : i * GG + bx;
                        if (u < NH * MOBA_NB) att::gate_unit(u % NH, MOBA_NB - 1 - u / NH, Pb, kmean, selm, plse, mcnt, mlist, (LAS char*)(F.lds + RING_OFF)); }
                }
                GRID_BAR();
                {
                    int tid_ = threadIdx.x; asm volatile("" : "+v"(tid_)); int bx = blockIdx.x, GG = gridDim.x; asm volatile("" : "+s"(bx), "+s"(GG));
                    const int tid = tid_, lane = tid & 63, wave = __builtin_amdgcn_readfirstlane(tid >> 6);
                    LAS char* alds = (LAS char*)(F.lds + RING_OFF);
                    LAS int* pre = (LAS int*)(alds + att::B_PRE);
                    if (tid < NH * MOBA_NB) { const int c = (int)__hip_atomic_load(mcnt + tid, __ATOMIC_RELAXED, __HIP_MEMORY_SCOPE_AGENT); pre[tid + 1] = (8 + ((c + 31) >> 5) + 7) >> 3; }
                    if (tid == 0) pre[0] = 0;
                    __syncthreads();
                    if (wave == 0) { int v[6], sum = 0;
#pragma unroll
                        for (int q = 0; q < 6; ++q) { v[q] = pre[1 + 6 * lane + q]; sum += v[q]; }
                        int x = sum;
#pragma unroll
                        for (int o = 1; o < 64; o <<= 1) { const int y = __shfl_up(x, o); if (lane >= o) x += y; }
                        int run = x - sum;
#pragma unroll
                        for (int q = 0; q < 6; ++q) { run += v[q]; pre[1 + 6 * lane + q] = run; } }
                    __syncthreads();
                    const int U_s = pre[NH * MOBA_NB], total = U_s + NMH * (SEQ / 32 / 8);
                    const int vbx = (GG % 8 == 0) ? (bx % 8) * (GG / 8) + bx / 8 : bx;
                    const int ulo = (int)((long)vbx * total / GG), uhi = (int)((long)(vbx + 1) * total / GG);
                    int un = ulo;
                    while (un < uhi) {
                        if (un < U_s) {
                            int lo = 0, hi2 = NH * MOBA_NB;
                            while (hi2 - lo > 1) { const int mid = (lo + hi2) >> 1; if (pre[mid] <= un) lo = mid; else hi2 = mid; }
                            const int h = lo >> 5, n = lo & 31, chunk = un - pre[lo], nun = pre[lo + 1] - pre[lo]; const int cntv = (int)__hip_atomic_load(mcnt + lo, __ATOMIC_RELAXED, __HIP_MEMORY_SCOPE_AGENT);
                            const int cend = (nun - chunk) < (uhi - un) ? nun : chunk + (uhi - un);
                            const int ng = 8 + ((cntv + 31) >> 5), g0 = 8 * chunk, g1 = ng < 8 * cend ? ng : 8 * cend;
                            att::block_unit<0>(h, n, g0, g1, cntv, mlist + (size_t)lo * SEQ, selm + (size_t)h * SEQ, Pb, part, plse, alds, slope_of(h) * (1.0f / SCALE));
                            un += cend - chunk;
                        } else { const int mu = un - U_s, hm = mu >> 5, c = mu & 31; const int cend = (32 - c) < (uhi - un) ? 32 : c + (uhi - un);
                            att::block_unit<1>(hm, 0, 8 * c, 8 * cend, 0, nullptr, nullptr, Pb, Cat, nullptr, alds, 0.f);
                            un += cend - c; }
                    }
                }
                GRID_BAR();
                {
                    PHASE_BEGIN();
                    for (int s = gw; s < SEQ; s += NGW) { float ov[4][8];
#pragma unroll
                        for (int kq = 0; kq < 3; ++kq) { const int c = lane + 64 * kq, h = c >> 4, cc = c & 15;
                            const f32x4 lv = *(const GAS f32x4*)(plse + ((size_t)s * NH + h) * 4);
                            const float mx = fmaxf(fmaxf(lv.x, lv.y), fmaxf(lv.z, lv.w)); float w0 = __expf(lv.x - mx), w1 = __expf(lv.y - mx), w2 = __expf(lv.z - mx), w3 = __expf(lv.w - mx);
                            const float ri = 1.0f / (w0 + w1 + w2 + w3); w0 *= ri; w1 *= ri; w2 *= ri; w3 *= ri;
                            const GAS v4u* pp = (const GAS v4u*)(part + ((size_t)s * NH + h) * 4 * HD) + cc;
                            const v4u p0 = pp[0], p1 = pp[16], p2 = pp[32], p3 = pp[48];
#define MIX(f) ((w0 > 0.f ? w0 * f(p0) : 0.f) + (w1 > 0.f ? w1 * f(p1) : 0.f) + (w2 > 0.f ? w2 * f(p2) : 0.f) + w3 * f(p3))
#define LOX(p) bf_lo(p.x)
#define HIX(p) bf_hi(p.x)
#define LOY(p) bf_lo(p.y)
#define HIY(p) bf_hi(p.y)
#define LOZ(p) bf_lo(p.z)
#define HIZ(p) bf_hi(p.z)
#define LOW(p) bf_lo(p.w)
#define HIW(p) bf_hi(p.w)
                            ov[kq][0] = MIX(LOX); ov[kq][1] = MIX(HIX); ov[kq][2] = MIX(LOY); ov[kq][3] = MIX(HIY); ov[kq][4] = MIX(LOZ); ov[kq][5] = MIX(HIZ); ov[kq][6] = MIX(LOW); ov[kq][7] = MIX(HIW);
#undef MIX
#undef LOX
#undef HIX
#undef LOY
#undef HIY
#undef LOZ
#undef HIZ
#undef LOW
#undef HIW
                        }
                        QUANT_ROW(s);
                    }
                }
            } else {
                {
                    int bx0 = blockIdx.x, GG0 = gridDim.x; asm volatile("" : "+s"(bx0), "+s"(GG0));
                    const int bx = (GG0 % 8 == 0) ? (bx0 % 8) * (GG0 / 8) + bx0 / 8 : bx0;
                    for (int i = 0; i < 2; ++i) {
                        const int du = i == 0 ? bx : (bx < 128 ? 256 + bx : -1);
                        if (du >= 0) { const int h = du >> 5, v = du & 31, gi = h >> 2, d = gi == 0 ? 1 : (gi == 1 ? 4 : 16), upr = 32 / d, r = v / upr, cp = v % upr;
                            att::UnitDesc u; u.qrow0 = (256 * cp) * d + r; u.qstride = d; u.qcol = QCOL + h * HD; u.kcol = KCOL + h * HD; u.vcol = VCOL + h * HD; u.ocol = h * HD; u.qidx0 = 256 * cp;
                            u.kidx0 = 256 * cp - 128; u.krow0 = r; u.kstride = d; u.t_begin = cp == 0 ? 2 : 0; u.t_end = 6; u.cbr = slope_of(h) * (float)d * (1.0f / SCALE); u.h = h;
                            att::attn_unit<att::DIL>(u, Pb, Cat, lse, (LAS char*)(F.lds + RING_OFF));
                        } else { const int mu = bx - 128, hm = mu >> 5, c = mu & 31;
                            att::block_unit<1>(hm, 0, 8 * c, 8 * c + 8, 0, nullptr, nullptr, Pb, Cat, nullptr, (LAS char*)(F.lds + RING_OFF), 0.f); }
                    }
                }
                GRID_BAR();
                {
                    PHASE_BEGIN();
                    for (int s = gw; s < SEQ; s += NGW) { float ov[4][8];
#pragma unroll
                        for (int k = 0; k < 3; ++k) { const int c = lane + 64 * k, h = c >> 4, j = h & 3;
                            const float l0 = lse[(size_t)s * NH + j], l1 = lse[(size_t)s * NH + 4 + j], l2 = lse[(size_t)s * NH + 8 + j], lh = lse[(size_t)s * NH + h];
                            const float mx = fmaxf(l0, fmaxf(l1, l2)); const float al = __expf(lh - mx) / (__expf(l0 - mx) + __expf(l1 - mx) + __expf(l2 - mx));
                            const v4u w = *((const GAS v4u*)(Cat + (size_t)s * DM) + c);
                            ov[k][0] = bf_lo(w.x) * al; ov[k][1] = bf_hi(w.x) * al; ov[k][2] = bf_lo(w.y) * al; ov[k][3] = bf_hi(w.y) * al; ov[k][4] = bf_lo(w.z) * al; ov[k][5] = bf_hi(w.z) * al; ov[k][6] = bf_lo(w.w) * al; ov[k][7] = bf_hi(w.w) * al; }
                        QUANT_ROW(s);
                    }
                }
            }
            GRID_BAR();
            {
                int cc = blockIdx.x, GG = gridDim.x; asm volatile("" : "+s"(cc), "+s"(GG));
                pg8::Gemm g{(const bf16*)Cat8, (const bf16*)(wl + LW_O), SEQ, DM, DM / 2}; pg8::XOrder S; S.init(SEQ, DM, GG, cc, 0);
                pg8::EpiBf16I8 E{Fb, DM, cat_rs, (const float*)(wl + LW_O + 6 * MiB), (LAS float*)(F.lds + RSTAB_OFF), (LAS float*)(F.lds + CSTAB_OFF)};
                pg8::gemm_phase<pg8::EpiBf16I8, pg8::XOrder, true, true, true>(F.lds + RING_OFF, g, S, E);
            }
        }
        if (!fuse) {
            GRID_BAR();
            PHASE_BEGIN();
            const float* gpo = g_post + (size_t)(l * 3 + part) * DM;
            const float coef = part == 1 ? 1.0f : 0.5f;
            const bool last = sub + 1 == 3 * DEPTH;
            for (int m = gw; m < SEQ; m += 2 * NGW) thin_rows<2>(Hb, Fb, gpo, coef, rstd, last ? X : nullptr, m, NGW, SEQ, lane, last ? nullptr : H8, rs8);
        }
        if (sub + 1 < 3 * DEPTH) GRID_BAR();
    }
}

extern "C" void kernel_launch(void* const* d_in, const int* in_sizes, int n_in, void* d_out, int out_size, void* d_ws, size_t ws_size, hipStream_t stream) {
    static int grid = 0;
    if (grid == 0) {
        if (n_in != 10 || in_sizes[0] != SEQ * DM || out_size != SEQ * DM || ws_size < WS_END) { fprintf(stderr, "kernel_launch: shape mismatch: n_in %d in0 %d out %d ws %zu (need %zu)\n", n_in, n_in > 0 ? in_sizes[0] : -1, out_size, ws_size, (size_t)WS_END); grid = -1; return; }
        int dev = 0, cus = 0, per_cu = 0;
        if (hipGetDevice(&dev) != hipSuccess || hipDeviceGetAttribute(&cus, hipDeviceAttributeMultiprocessorCount, dev) != hipSuccess) { fprintf(stderr, "kernel_launch: device query failed\n"); grid = -1; return; }
        if (hipFuncSetAttribute((const void*)trunk_fwd, hipFuncAttributeMaxDynamicSharedMemorySize, LDS_BYTES) != hipSuccess) { fprintf(stderr, "kernel_launch: hipFuncSetAttribute failed\n"); grid = -1; return; }
        if (hipOccupancyMaxActiveBlocksPerMultiprocessor(&per_cu, (const void*)trunk_fwd, NWAVES * 64, LDS_BYTES) != hipSuccess || per_cu < 1)
            fprintf(stderr, "kernel_launch: note: occupancy query reports %d workgroups per CU\n", per_cu);
        (void)hipGetLastError();
        grid = cus;
    }
    if (grid < 0) return;
    if (hipMemsetAsync((char*)d_ws + WS_CTL, 0, CTL_ZERO_BYTES, stream) != hipSuccess) { fprintf(stderr, "kernel_launch: memset failed\n"); return; }
    Args a{};
    for (int i = 0; i < 10; ++i) a.in[i] = (const float*)d_in[i];
    a.out = (float*)d_out; a.ws = (unsigned char*)d_ws;
    hipLaunchKernelGGL(trunk_fwd, dim3(grid), dim3(NWAVES * 64), LDS_BYTES, stream, a);
    const hipError_t le = hipPeekAtLastError();
    if (le != hipSuccess) fprintf(stderr, "kernel_launch: launch failed: %s\n", hipGetErrorName(le));
}
```

```cpp
#include <hip/hip_runtime.h>
#include <cstdio>
#include <cstdint>
#include <cmath>
#define FUSE_THIN 0
namespace pg8 {
#define PG8_LAS __attribute__((address_space(3)))
typedef unsigned short bf16_t;
typedef short bf16x8 __attribute__((ext_vector_type(8)));
typedef float f32x4 __attribute__((ext_vector_type(4)));
typedef unsigned u32x4 __attribute__((ext_vector_type(4)));
typedef int i32x4 __attribute__((ext_vector_type(4)));
constexpr int BM = 256, BK = 64, HALF = 128, HTB = HALF * BK * 2  , STAGE_BYTES = 8 * HTB, NXCD = 8, WGM = 8;

__host__ __device__ __forceinline__ int lds_byte(int r, int c) { const int st = (r >> 4) * 2 + (c >> 5), rr = r & 15, cc = c & 31, ob = rr * 64 + cc * 2; return st * 1024 + (ob ^ (((ob >> 9) & 1) << 5)); }
__host__ __device__ __forceinline__ void stage_rc(int b, int& R, int& C) { const int st = b / 1024, sb = b % 1024, swz = sb ^ (((sb >> 9) & 1) << 5); R = (st >> 1) * 16 + swz / 64; C = (st & 1) * 32 + (swz % 64) / 2; }
__host__ __device__ __forceinline__ int perm32(int rho) { const int n = rho >> 4, i = rho & 15; return 8 * (i >> 2) + 4 * n + (i & 3); }

struct Unit { int pm, pn; };
struct Gemm { const bf16_t* A; const bf16_t* Bt; int M, N, K; };

struct StaticOrder {
    int nM, nN, nwg, G, c;
    __host__ __device__ void init(int M, int N, int G_, int c_) { nM = M / BM; nN = N / BM; nwg = nM * nN; G = G_; c = c_; }
    __host__ __device__ bool next(int i, Unit& u) const {
        const long L = (long)i * G + c; if (L >= nwg) return false;
        int wgid = (int)L; { const int q = nwg / NXCD, r = nwg % NXCD, xcd = wgid % NXCD, off = wgid / NXCD; wgid = (xcd < r ? xcd * (q + 1) : r * (q + 1) + (xcd - r) * q) + off; }
        const int nig = WGM * nN, gid = wgid / nig, fm = gid * WGM, gsz = (nM - fm) < WGM ? (nM - fm) : WGM;
        u.pm = fm + ((wgid % nig) % gsz); u.pn = (wgid % nig) / gsz; return true;
    }
    __device__ __forceinline__ void a_ready(const Unit&) const {}
    __device__ __forceinline__ void done(const Unit&) const {}
};

__device__ __forceinline__ unsigned cvt_pk_bf16(float lo, float hi) { unsigned r; asm volatile("v_cvt_pk_bf16_f32 %0, %1, %2" : "=v"(r) : "v"(lo), "v"(hi)); return r; }
typedef float f32x2 __attribute__((ext_vector_type(2)));
struct XOrder {
    int nM, nN, nwg, G, c, extra;
    __host__ __device__ void init(int M, int N, int G_, int c_, int extra_) { nM = M / BM; nN = N / BM; nwg = nM * nN; G = G_; c = c_; extra = extra_; }
    __host__ __device__ bool next(int i, Unit& u) const {
        const long L = (long)i * G + c;
        if (L >= nwg) { const long e = L - nwg; if (e >= extra) return false; u.pm = nM; u.pn = nN + (int)e; return true; }
        int wgid = (int)L; { const int q = nwg / NXCD, r = nwg % NXCD, xcd = wgid % NXCD, off = wgid / NXCD; wgid = (xcd < r ? xcd * (q + 1) : r * (q + 1) + (xcd - r) * q) + off; }
        const int nig = WGM * nN, gid = wgid / nig, fm = gid * WGM, gsz = (nM - fm) < WGM ? (nM - fm) : WGM;
        u.pm = fm + ((wgid % nig) % gsz); u.pn = (wgid % nig) / gsz; return true;
    }
    __device__ __forceinline__ void a_ready(const Unit&) const {}
    __device__ __forceinline__ void done(const Unit&) const {}
};

struct NoPre {};
struct RowPre { int buf; };
struct EpiF32 {
    static constexpr bool PERM = false, AFTER_DRAIN = false;
    typedef NoPre Pre;
    float* C; int ldc;
    __device__ __forceinline__ void preload(Pre&, const Unit&, int, int, int) const {}
    __device__ __forceinline__ void operator()(const f32x4 (&acc)[2][2][4][2], const Unit& u, int wr, int wc, int fr, int fq, const Pre&) const {
        const int row0 = u.pm * BM + wr * 64 + fr, col0 = u.pn * BM + wc * 32 + 4 * fq;
#pragma unroll
        for (int ai = 0; ai < 2; ++ai)
#pragma unroll
            for (int m = 0; m < 4; ++m) { float* rowp = C + (size_t)(row0 + ai * HALF + m * 16) * ldc + col0;
#pragma unroll
                for (int bj = 0; bj < 2; ++bj)
#pragma unroll
                    for (int n = 0; n < 2; ++n) *(f32x4*)(rowp + bj * HALF + n * 16) = acc[ai][bj][m][n]; }
    }
};
struct EpiBf16 {
    static constexpr bool PERM = true, AFTER_DRAIN = false;
    typedef RowPre Pre;
    bf16_t* O; int ldc; const float* rs; PG8_LAS float* tab;
    __device__ __forceinline__ void preload(Pre& p, const Unit& u, int wid, int lane, int ui) const {
        p.buf = ui & 1;
        if (rs && wid < 4) __builtin_amdgcn_global_load_lds((const unsigned*)(rs + u.pm * BM + wid * 64 + lane), (PG8_LAS unsigned*)(tab + p.buf * 256 + wid * 64), 4, 0, 0);
    }
    __device__ __forceinline__ void operator()(const f32x4 (&acc)[2][2][4][2], const Unit& u, int wr, int wc, int fr, int fq, const Pre& p) const {
        const int row0 = u.pm * BM + wr * 64 + fr, col0 = u.pn * BM + wc * 32 + 8 * fq;
#pragma unroll
        for (int ai = 0; ai < 2; ++ai)
#pragma unroll
            for (int m = 0; m < 4; ++m) { bf16_t* rowp = O + (size_t)(row0 + ai * HALF + m * 16) * ldc + col0; const float s = rs ? tab[p.buf * 256 + wr * 64 + fr + ai * HALF + m * 16] : 1.0f;
#pragma unroll
                for (int bj = 0; bj < 2; ++bj) { const f32x4 v0 = acc[ai][bj][m][0] * s, v1 = acc[ai][bj][m][1] * s;
                    u32x4 w; w.x = cvt_pk_bf16(v0[0], v0[1]); w.y = cvt_pk_bf16(v0[2], v0[3]); w.z = cvt_pk_bf16(v1[0], v1[1]); w.w = cvt_pk_bf16(v1[2], v1[3]);
                    *(u32x4*)(rowp + bj * HALF) = w; } }
    }
};

__device__ __forceinline__ float bfl(unsigned w) { return __uint_as_float(w << 16); }
__device__ __forceinline__ float bfh(unsigned w) { return __uint_as_float(w & 0xffff0000u); }
struct EpiNormRes {
    static constexpr bool PERM = true, AFTER_DRAIN = true;
    typedef NoPre Pre;
    bf16_t* X; const float* gpost; float coef; float* xout; float* rstd; unsigned* slot1; unsigned* slot2; unsigned* cnt1; unsigned* cnt2; unsigned want; unsigned* tmo; int ldx; float inv_n, eps;
    __device__ __forceinline__ void preload(Pre&, const Unit&, int, int, int) const {}
    __device__ __forceinline__ void fused(f32x4 (&acc)[2][2][4][2], const Unit& u, int wr, int wc, int fr, int fq, PG8_LAS unsigned char* lds, int wid, int lane) const {
        PG8_LAS float* P = (PG8_LAS float*)lds; PG8_LAS float* S = P + 1024; PG8_LAS unsigned* flag = (PG8_LAS unsigned*)(S + 256);
        const int tid = wid * 64 + lane, rbase = u.pm * BM + wr * 64 + fr, cbase = u.pn * BM + wc * 32 + 8 * fq;
        u32x4 xv[4][2]; f32x4 gv[2][2];
#pragma unroll
        for (int m = 0; m < 4; ++m)
#pragma unroll
            for (int bj = 0; bj < 2; ++bj) xv[m][bj] = *(const u32x4*)(X + (size_t)(rbase + m * 16) * ldx + cbase + bj * HALF);
#pragma unroll
        for (int bj = 0; bj < 2; ++bj) { gv[bj][0] = *(const f32x4*)(gpost + cbase + bj * HALF); gv[bj][1] = *(const f32x4*)(gpost + cbase + bj * HALF + 4); }
#pragma unroll
        for (int ai = 0; ai < 2; ++ai)
#pragma unroll
            for (int m = 0; m < 4; ++m) { float s = 0.f;
#pragma unroll
                for (int bj = 0; bj < 2; ++bj)
#pragma unroll
                    for (int n = 0; n < 2; ++n) { const f32x4 x = acc[ai][bj][m][n]; s += (x[0] * x[0] + x[1] * x[1]) + (x[2] * x[2] + x[3] * x[3]); }
                s += __shfl_xor(s, 16); s += __shfl_xor(s, 32);
                if (fq == 0) P[(ai * HALF + wr * 64 + m * 16 + fr) * 4 + wc] = s; }
        asm volatile("s_waitcnt lgkmcnt(0)" ::: "memory"); __builtin_amdgcn_s_barrier(); asm volatile("" ::: "memory");
        if (tid < 256) { const f32x4 p = *(const PG8_LAS f32x4*)(P + tid * 4); const float tot = (p[0] + p[1]) + (p[2] + p[3]);
            __hip_atomic_store(slot1 + (size_t)(u.pm * BM + tid) * 8 + u.pn, __float_as_uint(tot), __ATOMIC_RELAXED, __HIP_MEMORY_SCOPE_AGENT); }
        asm volatile("s_waitcnt vmcnt(0)" ::: "memory");
        if (wid < 4 && lane == 0) __hip_atomic_fetch_add(cnt1 + 64 * u.pm, 1u, __ATOMIC_RELAXED, __HIP_MEMORY_SCOPE_AGENT);
        if (wid == 0) {
            const unsigned long long t0 = __builtin_amdgcn_s_memrealtime();
            for (;;) {
                if ((unsigned)__builtin_amdgcn_readfirstlane(__hip_atomic_load(cnt1 + 64 * u.pm, __ATOMIC_RELAXED, __HIP_MEMORY_SCOPE_AGENT)) >= want) break;
                if (__builtin_amdgcn_s_memrealtime() - t0 > 2000000ull) { if (lane == 0) __hip_atomic_store(tmo, 1u, __ATOMIC_RELAXED, __HIP_MEMORY_SCOPE_AGENT); break; }
                __builtin_amdgcn_s_sleep(2);
            }
            __builtin_amdgcn_fence(__ATOMIC_ACQUIRE, "agent");
            if (lane == 0) flag[0] = 1u;
        }
        asm volatile("s_waitcnt vmcnt(0) lgkmcnt(0)" ::: "memory"); __builtin_amdgcn_s_barrier(); asm volatile("" ::: "memory");
        if (tid < 256) { const unsigned* sl = slot1 + (size_t)(u.pm * BM + tid) * 8; float sum = 0.f;
#pragma unroll
            for (int t = 0; t < 8; ++t) sum += __uint_as_float(__hip_atomic_load(sl + t, __ATOMIC_RELAXED, __HIP_MEMORY_SCOPE_AGENT));
            S[tid] = coef / sqrtf(sum * inv_n + eps); }
        asm volatile("s_waitcnt lgkmcnt(0)" ::: "memory"); __builtin_amdgcn_s_barrier(); asm volatile("" ::: "memory");
        u32x4 xw[4][2];
#define NR_ROWGROUP(ai, m, XV) do { const int rl = (ai) * HALF + wr * 64 + (m) * 16 + fr; const float r = S[rl]; float s2 = 0.f; \
            _Pragma("unroll") for (int bj = 0; bj < 2; ++bj) { const f32x4 a0 = acc[ai][bj][m][0], a1 = acc[ai][bj][m][1], g0 = gv[bj][0], g1 = gv[bj][1]; const u32x4 x = XV[m][bj]; \
                const float y0 = bfl(x.x) + a0[0] * r * g0[0], y1 = bfh(x.x) + a0[1] * r * g0[1], y2 = bfl(x.y) + a0[2] * r * g0[2], y3 = bfh(x.y) + a0[3] * r * g0[3]; \
                const float y4 = bfl(x.z) + a1[0] * r * g1[0], y5 = bfh(x.z) + a1[1] * r * g1[1], y6 = bfl(x.w) + a1[2] * r * g1[2], y7 = bfh(x.w) + a1[3] * r * g1[3]; \
                s2 += (y0 * y0 + y1 * y1) + (y2 * y2 + y3 * y3) + (y4 * y4 + y5 * y5) + (y6 * y6 + y7 * y7); \
                u32x4 w; w.x = cvt_pk_bf16(y0, y1); w.y = cvt_pk_bf16(y2, y3); w.z = cvt_pk_bf16(y4, y5); w.w = cvt_pk_bf16(y6, y7); \
                const size_t off = (size_t)(rbase + (ai) * HALF + (m) * 16) * ldx + cbase + bj * HALF; \
                *(u32x4*)(X + off) = w; \
                if (xout) { *(f32x4*)(xout + off) = (f32x4){y0, y1, y2, y3}; *(f32x4*)(xout + off + 4) = (f32x4){y4, y5, y6, y7}; } } \
            s2 += __shfl_xor(s2, 16); s2 += __shfl_xor(s2, 32); \
            if (fq == 0) P[rl * 4 + wc] = s2; } while (0)
#define NR_LOADW(m) do { _Pragma("unroll") for (int bj = 0; bj < 2; ++bj) xw[m][bj] = *(const u32x4*)(X + (size_t)(rbase + HALF + (m) * 16) * ldx + cbase + bj * HALF); } while (0)
        NR_LOADW(0); NR_LOADW(1); asm volatile("" ::: "memory");
        NR_ROWGROUP(0, 0, xv); NR_ROWGROUP(0, 1, xv); asm volatile("" ::: "memory");
        NR_LOADW(2); NR_LOADW(3); asm volatile("" ::: "memory");
        NR_ROWGROUP(0, 2, xv); NR_ROWGROUP(0, 3, xv); asm volatile("" ::: "memory");
        NR_ROWGROUP(1, 0, xw); NR_ROWGROUP(1, 1, xw); NR_ROWGROUP(1, 2, xw); NR_ROWGROUP(1, 3, xw);
#undef NR_ROWGROUP
#undef NR_LOADW
        asm volatile("s_waitcnt lgkmcnt(0)" ::: "memory"); __builtin_amdgcn_s_barrier(); asm volatile("" ::: "memory");
        if (tid < 256) { const f32x4 p = *(const PG8_LAS f32x4*)(P + tid * 4); const float tot = (p[0] + p[1]) + (p[2] + p[3]);
            __hip_atomic_store(slot2 + (size_t)(u.pm * BM + tid) * 8 + u.pn, __float_as_uint(tot), __ATOMIC_RELAXED, __HIP_MEMORY_SCOPE_AGENT); }
        asm volatile("s_waitcnt vmcnt(0)" ::: "memory");
        if (wid < 4) { unsigned old = 0u;
            if (lane == 0) old = __hip_atomic_fetch_add(cnt2 + 64 * u.pm, 1u, __ATOMIC_RELAXED, __HIP_MEMORY_SCOPE_AGENT);
            old = (unsigned)__builtin_amdgcn_readfirstlane((int)old);
            if (old + 1u == want) {
                __builtin_amdgcn_fence(__ATOMIC_ACQUIRE, "agent");
                for (int rr = lane; rr < 256; rr += 64) { const unsigned* sl = slot2 + (size_t)(u.pm * BM + rr) * 8; float sum = 0.f;
#pragma unroll
                    for (int t = 0; t < 8; ++t) sum += __uint_as_float(__hip_atomic_load(sl + t, __ATOMIC_RELAXED, __HIP_MEMORY_SCOPE_AGENT));
                    rstd[u.pm * BM + rr] = 1.0f / sqrtf(sum * inv_n + eps); }
            } }
    }
};
__device__ __forceinline__ float silu_mul(float g, float u) { return g * u * __builtin_amdgcn_rcpf(1.0f + __builtin_amdgcn_exp2f(-1.4426950408889634f * g)); }
struct EpiSwiGLU {
    static constexpr bool PERM = true, AFTER_DRAIN = false;
    typedef RowPre Pre;
    bf16_t* O; int ldc; const float* rs; PG8_LAS float* tab;
    __device__ __forceinline__ void preload(Pre& p, const Unit& u, int wid, int lane, int ui) const {
        p.buf = ui & 1;
        if (wid < 4) __builtin_amdgcn_global_load_lds((const unsigned*)(rs + u.pm * BM + wid * 64 + lane), (PG8_LAS unsigned*)(tab + p.buf * 256 + wid * 64), 4, 0, 0);
    }
    __device__ __forceinline__ void operator()(const f32x4 (&acc)[2][2][4][2], const Unit& u, int wr, int wc, int fr, int fq, const Pre& p) const {
        const int row0 = u.pm * BM + wr * 64 + fr, col0 = u.pn * HALF + wc * 32 + 8 * fq;
#pragma unroll
        for (int ai = 0; ai < 2; ++ai)
#pragma unroll
            for (int m = 0; m < 4; ++m) { bf16_t* rowp = O + (size_t)(row0 + ai * HALF + m * 16) * ldc + col0;
                const float s = tab[p.buf * 256 + wr * 64 + fr + ai * HALF + m * 16];
                const f32x4 g0 = acc[ai][0][m][0] * s, g1 = acc[ai][0][m][1] * s, u0 = acc[ai][1][m][0] * s, u1 = acc[ai][1][m][1] * s;
                u32x4 w; w.x = cvt_pk_bf16(silu_mul(g0[0], u0[0]), silu_mul(g0[1], u0[1])); w.y = cvt_pk_bf16(silu_mul(g0[2], u0[2]), silu_mul(g0[3], u0[3]));
                w.z = cvt_pk_bf16(silu_mul(g1[0], u1[0]), silu_mul(g1[1], u1[1])); w.w = cvt_pk_bf16(silu_mul(g1[2], u1[2]), silu_mul(g1[3], u1[3]));
                *(u32x4*)rowp = w; }
    }
};

struct EpiSwiGLU8 {
    static constexpr bool PERM = true, AFTER_DRAIN = false;
    typedef RowPre Pre;
    bf16_t* O; int ldc; const float* rs; const float* cs; PG8_LAS float* tab; PG8_LAS float* ctab;
    __device__ __forceinline__ void preload(Pre& p, const Unit& u, int wid, int lane, int ui) const {
        p.buf = ui & 1;
        if (wid < 4) __builtin_amdgcn_global_load_lds((const unsigned*)(rs + u.pm * BM + wid * 64 + lane), (PG8_LAS unsigned*)(tab + p.buf * 256 + wid * 64), 4, 0, 0);
        else __builtin_amdgcn_global_load_lds((const unsigned*)(cs + u.pn * BM + (wid - 4) * 64 + lane), (PG8_LAS unsigned*)(ctab + p.buf * 256 + (wid - 4) * 64), 4, 0, 0);
    }
    __device__ __forceinline__ void operator()(const f32x4 (&acc)[2][2][4][2], const Unit& u, int wr, int wc, int fr, int fq, const Pre& p) const {
        const int row0 = u.pm * BM + wr * 64 + fr, col0 = u.pn * HALF + wc * 32 + 8 * fq;
        const PG8_LAS float* cg = ctab + p.buf * 256 + wc * 32 + 8 * fq;
        const f32x4 cg0 = *(const PG8_LAS f32x4*)cg, cg1 = *(const PG8_LAS f32x4*)(cg + 4), cu0 = *(const PG8_LAS f32x4*)(cg + HALF), cu1 = *(const PG8_LAS f32x4*)(cg + HALF + 4);
#pragma unroll
        for (int ai = 0; ai < 2; ++ai)
#pragma unroll
            for (int m = 0; m < 4; ++m) { bf16_t* rowp = O + (size_t)(row0 + ai * HALF + m * 16) * ldc + col0;
                const float s = tab[p.buf * 256 + wr * 64 + fr + ai * HALF + m * 16];
                const f32x4 G0 = __builtin_convertvector(__builtin_bit_cast(i32x4, acc[ai][0][m][0]), f32x4) * (cg0 * s), G1 = __builtin_convertvector(__builtin_bit_cast(i32x4, acc[ai][0][m][1]), f32x4) * (cg1 * s);
                const f32x4 U0 = __builtin_convertvector(__builtin_bit_cast(i32x4, acc[ai][1][m][0]), f32x4) * (cu0 * s), U1 = __builtin_convertvector(__builtin_bit_cast(i32x4, acc[ai][1][m][1]), f32x4) * (cu1 * s);
                f32x4 e0, e1, r0, r1;
#pragma unroll
                for (int k = 0; k < 4; ++k) { e0[k] = __builtin_amdgcn_exp2f(-G0[k]); e1[k] = __builtin_amdgcn_exp2f(-G1[k]); }
                const f32x4 d0 = e0 + 1.0f, d1 = e1 + 1.0f, p0 = G0 * U0, p1 = G1 * U1;
#pragma unroll
                for (int k = 0; k < 4; ++k) { r0[k] = __builtin_amdgcn_rcpf(d0[k]); r1[k] = __builtin_amdgcn_rcpf(d1[k]); }
                const f32x4 o0 = p0 * r0, o1 = p1 * r1;
                u32x4 w; w.x = cvt_pk_bf16(o0[0], o0[1]); w.y = cvt_pk_bf16(o0[2], o0[3]); w.z = cvt_pk_bf16(o1[0], o1[1]); w.w = cvt_pk_bf16(o1[2], o1[3]);
                *(u32x4*)rowp = w; }
    }
};

struct EpiBf16I8 {
    static constexpr bool PERM = true, AFTER_DRAIN = false;
    typedef RowPre Pre;
    bf16_t* O; int ldc; const float* rs; const float* cs; PG8_LAS float* tab; PG8_LAS float* ctab;
    __device__ __forceinline__ void preload(Pre& p, const Unit& u, int wid, int lane, int ui) const {
        p.buf = ui & 1;
        if (wid < 4) __builtin_amdgcn_global_load_lds((const unsigned*)(rs + u.pm * BM + wid * 64 + lane), (PG8_LAS unsigned*)(tab + p.buf * 256 + wid * 64), 4, 0, 0);
        else __builtin_amdgcn_global_load_lds((const unsigned*)(cs + u.pn * BM + (wid - 4) * 64 + lane), (PG8_LAS unsigned*)(ctab + p.buf * 256 + (wid - 4) * 64), 4, 0, 0);
    }
    __device__ __forceinline__ void operator()(const f32x4 (&acc)[2][2][4][2], const Unit& u, int wr, int wc, int fr, int fq, const Pre& p) const {
        const int row0 = u.pm * BM + wr * 64 + fr, col0 = u.pn * BM + wc * 32 + 8 * fq;
        const PG8_LAS float* cg = ctab + p.buf * 256 + wc * 32 + 8 * fq;
        f32x4 cc[2][2];
#pragma unroll
        for (int bj = 0; bj < 2; ++bj) { cc[bj][0] = *(const PG8_LAS f32x4*)(cg + bj * HALF); cc[bj][1] = *(const PG8_LAS f32x4*)(cg + bj * HALF + 4); }
#pragma unroll
        for (int ai = 0; ai < 2; ++ai)
#pragma unroll
            for (int m = 0; m < 4; ++m) { bf16_t* rowp = O + (size_t)(row0 + ai * HALF + m * 16) * ldc + col0; const float s = tab[p.buf * 256 + wr * 64 + fr + ai * HALF + m * 16];
#pragma unroll
                for (int bj = 0; bj < 2; ++bj) { const f32x4 v0 = __builtin_convertvector(__builtin_bit_cast(i32x4, acc[ai][bj][m][0]), f32x4) * (cc[bj][0] * s), v1 = __builtin_convertvector(__builtin_bit_cast(i32x4, acc[ai][bj][m][1]), f32x4) * (cc[bj][1] * s);
                    u32x4 w; w.x = cvt_pk_bf16(v0[0], v0[1]); w.y = cvt_pk_bf16(v0[2], v0[3]); w.z = cvt_pk_bf16(v1[0], v1[1]); w.w = cvt_pk_bf16(v1[2], v1[3]);
                    *(u32x4*)(rowp + bj * HALF) = w; } }
    }
};

template <class Epi, class Sched, bool ALIGN_EPI = false, bool SP2 = false, bool I8 = false>
__device__ __forceinline__ void gemm_phase(PG8_LAS unsigned char* lds, const Gemm g, const Sched& S, const Epi& E) {
    int tid_ = threadIdx.x; asm volatile("" : "+v"(tid_));
    const int tid = tid_, wid = __builtin_amdgcn_readfirstlane(tid >> 6), lane = tid & 63, wr = wid >> 2, wc = wid & 3, fr = lane & 15, fq = lane >> 4;
    const int K = g.K, nt = K / BK;
    unsigned voffA[2], voffB[2];
#pragma unroll
    for (int i = 0; i < 2; ++i) { int R, C; stage_rc(tid * 16 + i * 8192, R, C); const int Rb = Epi::PERM ? ((R & ~31) + perm32(R & 31)) : R;
        voffA[i] = (unsigned)(R * K + C) * 2u; voffB[i] = (unsigned)(Rb * K + C) * 2u; }
    const size_t kstep = (size_t)(BK * 2);
    const size_t hstep = (size_t)HALF * K * 2;
    const size_t tstep = 2 * hstep;
    const unsigned ldsw = (unsigned)wid * 1024u;
    const int aoff = lds_byte(wr * 64 + fr, fq * 8), boff = lds_byte(wc * 32 + fr, fq * 8);
#define PG8_SA(b, h) (((b) * 2 + (h)) * HTB)
#define PG8_SB(b, h) ((4 + (b) * 2 + (h)) * HTB)
#define PG8_STAGE(bufoff, gbase, voff) do { _Pragma("unroll") for (int _i = 0; _i < 2; ++_i) \
        __builtin_amdgcn_global_load_lds((const unsigned*)((const char*)(gbase) + (voff)[_i]), (PG8_LAS unsigned*)(lds + (bufoff) + ldsw + _i * 8192), 16, 0, 0); } while (0)
#define PG8_LDA(dst, b, h) do { _Pragma("unroll") for (int m = 0; m < 4; ++m) _Pragma("unroll") for (int k = 0; k < 2; ++k) dst[m][k] = *(const PG8_LAS bf16x8*)(lds + PG8_SA(b, h) + aoff + m * 2048 + k * 1024); } while (0)
#define PG8_LDB(dst, b, h) do { _Pragma("unroll") for (int n = 0; n < 2; ++n) _Pragma("unroll") for (int k = 0; k < 2; ++k) dst[n][k] = *(const PG8_LAS bf16x8*)(lds + PG8_SB(b, h) + boff + n * 2048 + k * 1024); } while (0)
#define PG8_MMA(ai, bj, At, Bt) do { __builtin_amdgcn_s_setprio(1); _Pragma("unroll") for (int m = 0; m < 4; ++m) _Pragma("unroll") for (int n = 0; n < 2; ++n) _Pragma("unroll") for (int k = 0; k < 2; ++k) \
        { if constexpr (I8) acc[ai][bj][m][n] = __builtin_bit_cast(f32x4, __builtin_amdgcn_mfma_i32_16x16x64_i8(__builtin_bit_cast(i32x4, Bt[n][k]), __builtin_bit_cast(i32x4, At[m][k]), __builtin_bit_cast(i32x4, acc[ai][bj][m][n]), 0, 0, 0)); \
          else acc[ai][bj][m][n] = __builtin_amdgcn_mfma_f32_16x16x32_bf16(Bt[n][k], At[m][k], acc[ai][bj][m][n], 0, 0, 0); } __builtin_amdgcn_s_setprio(0); } while (0)
#define PG8_WAIT_V(n) asm volatile("s_waitcnt vmcnt(" #n ")" ::: "memory")
#define PG8_WAIT_L(n) asm volatile("s_waitcnt lgkmcnt(" #n ")" ::: "memory")
#define PG8_BAR __builtin_amdgcn_s_barrier()
#define PG8_SCHED __builtin_amdgcn_sched_barrier(0)
    Unit cur, nxt; int ui = 0;
    if (!S.next(0, cur)) return;
    f32x4 acc[2][2][4][2];
#pragma unroll
    for (int a = 0; a < 2; ++a)
#pragma unroll
        for (int b = 0; b < 2; ++b)
#pragma unroll
            for (int m = 0; m < 4; ++m)
#pragma unroll
                for (int n = 0; n < 2; ++n) acc[a][b][m][n] = (f32x4){0.f, 0.f, 0.f, 0.f};
    bf16x8 At[4][2], B0[2][2], B1[2][2];
    const char* cA = (const char*)g.A + (size_t)cur.pm * tstep; const char* cB = (const char*)g.Bt + (size_t)cur.pn * tstep;
    S.a_ready(cur);
    typename Epi::Pre pre; E.preload(pre, cur, wid, lane, ui);
    if constexpr (SP2) {
        PG8_STAGE(PG8_SB(0, 0), cB, voffB); PG8_STAGE(PG8_SB(0, 1), cB + hstep, voffB); PG8_STAGE(PG8_SA(0, 0), cA, voffA); PG8_STAGE(PG8_SA(0, 1), cA + hstep, voffA);
        if (wr == 1) PG8_BAR;
        PG8_WAIT_V(2); PG8_BAR;
        PG8_STAGE(PG8_SB(1, 0), cB + kstep, voffB); PG8_STAGE(PG8_SA(1, 0), cA + kstep, voffA); PG8_STAGE(PG8_SB(1, 1), cB + hstep + kstep, voffB);
        PG8_WAIT_V(6); PG8_BAR;
    } else {
        PG8_STAGE(PG8_SB(0, 0), cB, voffB); PG8_STAGE(PG8_SA(0, 0), cA, voffA); PG8_STAGE(PG8_SB(0, 1), cB + hstep, voffB); PG8_STAGE(PG8_SA(0, 1), cA + hstep, voffA);
        if (wr == 1) PG8_BAR;
        PG8_WAIT_V(4); PG8_BAR;
        PG8_STAGE(PG8_SB(1, 0), cB + kstep, voffB); PG8_STAGE(PG8_SA(1, 0), cA + kstep, voffA); PG8_STAGE(PG8_SB(1, 1), cB + hstep + kstep, voffB);
        PG8_WAIT_V(6); PG8_BAR;
    }
    for (;;) {
        const bool has_next = S.next(ui + 1, nxt);
        const char* nA = has_next ? (const char*)g.A + (size_t)nxt.pm * tstep : cA; const char* nB = has_next ? (const char*)g.Bt + (size_t)nxt.pn * tstep : cB;
        for (int t = 0; t < nt; t += 2) {
            const bool last = (t == nt - 2);
            const char* a1 = cA + (size_t)(t + 1) * kstep;
            const char* a2 = last ? nA : cA + (size_t)(t + 2) * kstep; const char* b2 = last ? nB : cB + (size_t)(t + 2) * kstep;
            const char* a3 = a2 + kstep; const char* b3 = b2 + kstep;
            if (last && has_next) S.a_ready(nxt);
            if constexpr (SP2) {
            PG8_LDB(B0, 0, 0); PG8_LDB(B1, 0, 1); PG8_SCHED; PG8_LDA(At, 0, 0); PG8_STAGE(PG8_SA(1, 1), a1 + hstep, voffA);
            PG8_WAIT_V(8); PG8_WAIT_L(0); PG8_BAR; PG8_MMA(0, 0, At, B0); PG8_MMA(0, 1, At, B1); PG8_BAR; PG8_SCHED;
            PG8_LDA(At, 0, 1); PG8_STAGE(PG8_SB(0, 0), b2, voffB); PG8_STAGE(PG8_SB(0, 1), b2 + hstep, voffB); PG8_STAGE(PG8_SA(0, 0), a2, voffA);
            PG8_WAIT_V(8); PG8_WAIT_L(0); PG8_BAR; PG8_MMA(1, 0, At, B0); PG8_MMA(1, 1, At, B1); PG8_BAR; PG8_SCHED;
            PG8_LDB(B0, 1, 0); PG8_LDB(B1, 1, 1); PG8_SCHED; PG8_LDA(At, 1, 0); PG8_STAGE(PG8_SA(0, 1), a2 + hstep, voffA);
            PG8_WAIT_V(8); PG8_WAIT_L(0); PG8_BAR; PG8_MMA(0, 0, At, B0); PG8_MMA(0, 1, At, B1); PG8_BAR; PG8_SCHED;
            PG8_LDA(At, 1, 1); PG8_STAGE(PG8_SB(1, 0), b3, voffB); PG8_STAGE(PG8_SB(1, 1), b3 + hstep, voffB); PG8_STAGE(PG8_SA(1, 0), a3, voffA);
            PG8_WAIT_V(8); PG8_WAIT_L(0); PG8_BAR; PG8_MMA(1, 0, At, B0); PG8_MMA(1, 1, At, B1); PG8_BAR; PG8_SCHED;
            } else {
            PG8_LDB(B0, 0, 0); PG8_SCHED; PG8_LDA(At, 0, 0); PG8_STAGE(PG8_SA(1, 1), a1 + hstep, voffA);
            PG8_WAIT_L(8); PG8_BAR; PG8_WAIT_L(0); PG8_MMA(0, 0, At, B0); PG8_BAR; PG8_SCHED;
            PG8_LDB(B1, 0, 1); PG8_STAGE(PG8_SB(0, 0), b2, voffB);
            PG8_BAR; PG8_WAIT_L(0); PG8_MMA(0, 1, At, B1); PG8_BAR;
            PG8_LDA(At, 0, 1); PG8_STAGE(PG8_SA(0, 0), a2, voffA);
            PG8_BAR; PG8_WAIT_L(0); PG8_MMA(1, 0, At, B0); PG8_BAR; PG8_SCHED;
            PG8_STAGE(PG8_SB(0, 1), b2 + hstep, voffB);
            PG8_WAIT_V(6); PG8_BAR; PG8_MMA(1, 1, At, B1); PG8_BAR;
            PG8_LDB(B0, 1, 0); PG8_SCHED; PG8_LDA(At, 1, 0); PG8_STAGE(PG8_SA(0, 1), a2 + hstep, voffA);
            PG8_WAIT_L(8); PG8_BAR; PG8_WAIT_L(0); PG8_MMA(0, 0, At, B0); PG8_BAR; PG8_SCHED;
            PG8_LDB(B1, 1, 1); PG8_STAGE(PG8_SB(1, 0), b3, voffB);
            PG8_BAR; PG8_WAIT_L(0); PG8_MMA(0, 1, At, B1); PG8_BAR;
            PG8_LDA(At, 1, 1); PG8_STAGE(PG8_SA(1, 0), a3, voffA);
            PG8_BAR; PG8_WAIT_L(0); PG8_MMA(1, 0, At, B0); PG8_BAR; PG8_SCHED;
            PG8_STAGE(PG8_SB(1, 1), b3 + hstep, voffB);
            PG8_WAIT_V(6); PG8_BAR; PG8_MMA(1, 1, At, B1); PG8_BAR;
            }
        }
        if constexpr (ALIGN_EPI) { if (wr == 0) PG8_BAR; }
        if constexpr (!Epi::AFTER_DRAIN) { E(acc, cur, wr, wc, fr, fq, pre); S.done(cur); }
        if (!has_next) break;
#pragma unroll
        for (int a = 0; a < 2; ++a)
#pragma unroll
            for (int b = 0; b < 2; ++b)
#pragma unroll
                for (int m = 0; m < 4; ++m)
#pragma unroll
                    for (int n = 0; n < 2; ++n) acc[a][b][m][n] = (f32x4){0.f, 0.f, 0.f, 0.f};
        cur = nxt; cA = nA; cB = nB; ++ui;
        E.preload(pre, cur, wid, lane, ui);
        if constexpr (ALIGN_EPI) { if (wr == 1) PG8_BAR; }
    }
    PG8_WAIT_V(0);
    if constexpr (!ALIGN_EPI) { if (wr == 0) PG8_BAR; }
    PG8_BAR;
    if constexpr (Epi::AFTER_DRAIN) { E.fused(acc, cur, wr, wc, fr, fq, lds, wid, lane); S.done(cur); }
#undef PG8_SA
#undef PG8_SB
#undef PG8_STAGE
#undef PG8_LDA
#undef PG8_LDB
#undef PG8_MMA
#undef PG8_WAIT_V
#undef PG8_WAIT_L
#undef PG8_BAR
#undef PG8_SCHED
}
}
#define GAS __attribute__((address_space(1)))
#define LAS __attribute__((address_space(3)))
typedef unsigned short bf16;
typedef unsigned v4u __attribute__((ext_vector_type(4)));
typedef float f32x4 __attribute__((ext_vector_type(4)));
typedef short bf16x8 __attribute__((ext_vector_type(8)));
typedef GAS unsigned gu32;
typedef GAS unsigned long long gu64;
#define RLX_AGENT __ATOMIC_RELAXED, __HIP_MEMORY_SCOPE_AGENT
#define LDS_WAIT() asm volatile("s_waitcnt lgkmcnt(0)" ::: "memory")
#define VM_WAIT() asm volatile("s_waitcnt vmcnt(0)" ::: "memory")
__device__ __forceinline__ unsigned long long rt() { return __builtin_amdgcn_s_memrealtime(); }
__device__ __forceinline__ unsigned f2bf(float f) { unsigned u = __builtin_bit_cast(unsigned, f); return (u + 0x7fffu + ((u >> 16) & 1u)) >> 16; }
__device__ __forceinline__ unsigned pk2(float lo, float hi) { return f2bf(lo) | (f2bf(hi) << 16); }

#define XB_TMO      128
#define XB_XCNT(j)  (256  + 64 * (j))
#define XB_XSUB(j)  (1280 + 64 * (j))
#define XB_XGEN(j)  (2304 + 64 * (j))
#define XB_TOP      3328
#define XB_TOPGEN   3392
#define XCD_BAR_WORDS 3456
#define XB_SPIN_CAP (1u << 18)

__device__ __forceinline__ unsigned xb_ld(unsigned* p)              { return __hip_atomic_load(p, __ATOMIC_RELAXED, __HIP_MEMORY_SCOPE_AGENT); }
__device__ __forceinline__ unsigned xb_add(unsigned* p, unsigned v) { return __hip_atomic_fetch_add(p, v, __ATOMIC_RELAXED, __HIP_MEMORY_SCOPE_AGENT); }
__device__ __forceinline__ unsigned xb_xcc_id() { return (unsigned)__builtin_amdgcn_s_getreg((3 << 11) | 20) & 0xFu; }
#define XB_SPIN(cond, bar) do { unsigned _sp = 0; while (cond) { __builtin_amdgcn_s_sleep(1); \
    if ((++_sp & 255u) == 0u) { if (xb_ld(&(bar)[XB_TMO])) break; if (_sp > XB_SPIN_CAP) { atomicAdd(&(bar)[XB_TMO], 1u); break; } } } } while (0)

struct XcdBarrier {
    unsigned* bar; unsigned x;
    volatile LAS unsigned* st;
};

__device__ __forceinline__ XcdBarrier xcd_barrier_post(unsigned* bar, volatile LAS unsigned* st) {
    XcdBarrier b; b.bar = bar; b.x = xb_xcc_id(); b.st = st;
    if (threadIdx.x == 0) (void)xb_add(&bar[XB_XCNT(b.x)], 1u);
    return b;
}
__device__ __forceinline__ void xcd_barrier_complete(unsigned* bar, unsigned x, unsigned& nloc, unsigned& nx) {
    const unsigned G = gridDim.x * gridDim.y * gridDim.z;
    unsigned sum, cnt, mine, sp = 0u;
    for (;;) {
        sum = 0u; cnt = 0u; mine = 0u;
#pragma unroll
        for (unsigned j = 0; j < 16; ++j) { const unsigned c = xb_ld(&bar[XB_XCNT(j)]); sum += c; cnt += (c > 0u) ? 1u : 0u; mine = (j == x) ? c : mine; }
        if (sum == G) break;
        __builtin_amdgcn_s_sleep(1);
        if ((++sp & 255u) == 0u) { if (xb_ld(&bar[XB_TMO])) break; if (sp > XB_SPIN_CAP) { atomicAdd(&bar[XB_TMO], 1u); break; } }
    }
    nloc = mine > 0u ? mine : 1u; nx = cnt > 0u ? cnt : 1u;
}

__device__ __forceinline__ void xcd_barrier(const XcdBarrier& b) {
    asm volatile("s_waitcnt vmcnt(0)" ::: "memory");
    __syncthreads();
    if (threadIdx.x == 0) {
        unsigned* bar = b.bar;
        __builtin_amdgcn_s_waitcnt(0);
        unsigned nloc = b.st[0], nx = b.st[1];
        if (nloc == 0u) { xcd_barrier_complete(bar, b.x, nloc, nx); b.st[0] = nloc; b.st[1] = nx; }
        const unsigned old = xb_add(&bar[XB_XSUB(b.x)], 1u);
        const unsigned gen = old / nloc;
        if (old + 1u == (gen + 1u) * nloc) {
            __builtin_amdgcn_fence(__ATOMIC_RELEASE, "agent");
            asm volatile("s_waitcnt vmcnt(0)" ::: "memory");
            const unsigned og = xb_add(&bar[XB_TOP], 1u);
            const unsigned tg = og / nx;
            if (og + 1u == (tg + 1u) * nx) xb_add(&bar[XB_TOPGEN], 1u);
            else XB_SPIN(xb_ld(&bar[XB_TOPGEN]) == tg, bar);
            __builtin_amdgcn_fence(__ATOMIC_ACQUIRE, "agent");
            xb_add(&bar[XB_XGEN(b.x)], 1u);
            asm volatile("s_waitcnt vmcnt(0)" ::: "memory");
        } else {
            XB_SPIN(xb_ld(&bar[XB_XGEN(b.x)]) == gen, bar);
            __builtin_amdgcn_fence(__ATOMIC_ACQUIRE, "agent");
            asm volatile("s_waitcnt vmcnt(0)" ::: "memory");
        }
    }
    __syncthreads();
}
typedef unsigned v2u __attribute__((ext_vector_type(2)));
__device__ __forceinline__ float bf_lo(unsigned w) { return __uint_as_float(w << 16); }
__device__ __forceinline__ float bf_hi(unsigned w) { return __uint_as_float(w & 0xffff0000u); }

constexpr int NWAVES = 8;
constexpr int SEQ = 8192, DM = 2048, DFF = 5632, DEPTH = 4, NH = 12, HD = 128, NMEM = 256, NMH = 4;
constexpr int SELF_W = NH * HD, IN_W = 3 * SELF_W + NMH * HD, KVW = 2 * NMH * HD;
constexpr int LDP = IN_W + KVW;
constexpr int MROWS = SEQ + NMEM;
constexpr int QCOL = 0, KCOL = SELF_W, VCOL = 2 * SELF_W, QMCOL = 3 * SELF_W, KMCOL = IN_W, VMCOL = IN_W + NMH * HD;
constexpr float RMS_EPS = 1e-6f, SCALE = 0.08838834764831845f;
constexpr int MOBA_BLK = 256, MOBA_NB = SEQ / MOBA_BLK;

constexpr size_t MiB = 1u << 20;
constexpr size_t WS_CTL = 0, CTL_ZERO_BYTES = 256 * 1024;
constexpr size_t WS_KMEAN = 1 * MiB;
constexpr size_t WS_LSE = 1 * MiB + 256 * 1024;
constexpr size_t WS_RSTD = 1 * MiB + 640 * 1024;
constexpr size_t WS_W = 2 * MiB, LW = 164 * MiB;
constexpr size_t LW_IN = 0, LW_OUT = 88 * MiB, LW_QKV = 132 * MiB, LW_O = 156 * MiB;
constexpr size_t WS_H = WS_W + DEPTH * LW;
constexpr size_t WS_A = WS_H + 33 * MiB;
constexpr size_t WS_F = WS_A + 88 * MiB;
constexpr size_t WS_P = WS_F + 64 * MiB;
constexpr size_t WS_CAT = WS_P + 99 * MiB;
constexpr size_t WS_SEL = WS_CAT + 32 * MiB;
constexpr size_t WS_PLSE = WS_SEL + 1 * MiB;
constexpr size_t WS_LIST = WS_PLSE + 2 * MiB;
constexpr size_t WS_PART = WS_LIST + 12 * MiB;
constexpr size_t WS_SLOT1 = WS_PART + 96 * MiB, WS_SLOT2 = WS_SLOT1 + 256 * 1024;
constexpr size_t WS_END = WS_SLOT1 + 1 * MiB;
static_assert((size_t)MROWS * DM * 2 == 33 * MiB && (size_t)SEQ * DFF * 2 == 88 * MiB && (size_t)MROWS * LDP * 2 == 99 * MiB && (size_t)2 * DFF * DM * 2 == 44 * MiB && (size_t)LDP * DM * 2 == 24 * MiB, "ws map");
constexpr int CW_X1 = 16384, CW_X2 = 16384 + 2048;
constexpr int CW_CNT = 8192;
constexpr int CW_BAR = 4096;

constexpr int RING_OFF = 0, RING_BYTES = 131072;
constexpr int LDSCTL_OFF = RING_BYTES, MISC_OFF = LDSCTL_OFF + 320;
constexpr int RSTAB_OFF = RING_BYTES + 1024;
constexpr int CSTAB_OFF = RSTAB_OFF + 2048;
constexpr int CMAX_OFF = RING_BYTES + 8192;
constexpr int LDS_BYTES = 147456;

struct Ctx {
    LAS unsigned char* lds;
    int tid, lane, wave, vcu, G;
};

#define WAVE_SYNC() do { asm volatile("s_waitcnt lgkmcnt(0)" ::: "memory"); __builtin_amdgcn_wave_barrier(); asm volatile("" ::: "memory"); } while (0)
__device__ __forceinline__ float wave_sum(float v) {
#pragma unroll
    for (int o = 1; o < 64; o <<= 1) v += __shfl_xor(v, o);
    return v;
}
__device__ __forceinline__ float wave_max(float v) {
#pragma unroll
    for (int o = 1; o < 64; o <<= 1) v = fmaxf(v, __shfl_xor(v, o));
    return v;
}

__device__ __forceinline__ void p0_transpose_item(const float* W, int K, int N, bf16* WT, int k0, int n0, int drow0, LAS float* scr, int lane, const float* gk) {
    (void)scr;
    const int r8 = lane >> 3, cg = lane & 7;
    f32x4 wv[8];
    const float* wp = W + (size_t)(k0 + 8 * r8) * N + n0 + 4 * cg;
#pragma unroll
    for (int i = 0; i < 8; ++i) wv[i] = __builtin_nontemporal_load((const f32x4*)(wp + (size_t)i * N));
    if (gk) { const f32x4 ga = *(const GAS f32x4*)(gk + k0 + 8 * r8), gb = *(const GAS f32x4*)(gk + k0 + 8 * r8 + 4);
        wv[0] = wv[0] * ga.x; wv[1] = wv[1] * ga.y; wv[2] = wv[2] * ga.z; wv[3] = wv[3] * ga.w; wv[4] = wv[4] * gb.x; wv[5] = wv[5] * gb.y; wv[6] = wv[6] * gb.z; wv[7] = wv[7] * gb.w; }
#pragma unroll
    for (int e = 0; e < 4; ++e) { v4u o; o.x = pk2(wv[0][e], wv[1][e]); o.y = pk2(wv[2][e], wv[3][e]); o.z = pk2(wv[4][e], wv[5][e]); o.w = pk2(wv[6][e], wv[7][e]);
        *(GAS v4u*)(WT + (size_t)(drow0 + 4 * cg + e) * K + k0 + 8 * r8) = o; }
}

__device__ __forceinline__ unsigned q8pack(float a, float b, float c, float d, float inv) {
    const float M = 12582912.0f;
    const unsigned fa = __float_as_uint(fmaf(a, inv, M)), fb = __float_as_uint(fmaf(b, inv, M)), fc = __float_as_uint(fmaf(c, inv, M)), fd = __float_as_uint(fmaf(d, inv, M));
    const unsigned t01 = __builtin_amdgcn_perm(fb, fa, 0x0c0c0400u), t23 = __builtin_amdgcn_perm(fd, fc, 0x0c0c0400u);
    return (t23 << 16) | t01;
}
__device__ __forceinline__ void strip_convert8(const float* W, int N, const float* gk, unsigned char* W8, float* cs, int n0, int drow0, LAS float* scr, LAS float* cm, int wave, int lane, const float csmul = 1.0f) {
    const int kw = 256 * wave, r8 = lane >> 3, cg = lane & 7;
    LAS float* gt = scr;
    *(LAS f32x4*)(gt + 4 * lane) = gk ? *(const GAS f32x4*)(gk + kw + 4 * lane) : (f32x4){1.f, 1.f, 1.f, 1.f};
    f32x4 wv[32];
    const float* wp = W + (size_t)(kw + 32 * r8) * N + n0 + 4 * cg;
#pragma unroll
    for (int i = 0; i < 32; ++i) wv[i] = __builtin_nontemporal_load((const f32x4*)(wp + (size_t)i * N));
    WAVE_SYNC();
    f32x4 mx4 = (f32x4){0.f, 0.f, 0.f, 0.f};
#pragma unroll
    for (int i4 = 0; i4 < 8; ++i4) { const f32x4 g4 = *(const LAS f32x4*)(gt + 32 * r8 + 4 * i4);
#pragma unroll
        for (int t = 0; t < 4; ++t) { const int i = 4 * i4 + t; wv[i] = wv[i] * g4[t]; mx4.x = fmaxf(mx4.x, fabsf(wv[i].x)); mx4.y = fmaxf(mx4.y, fabsf(wv[i].y)); mx4.z = fmaxf(mx4.z, fabsf(wv[i].z)); mx4.w = fmaxf(mx4.w, fabsf(wv[i].w)); } }
#pragma unroll
    for (int o = 8; o < 64; o <<= 1) { mx4.x = fmaxf(mx4.x, __shfl_xor(mx4.x, o)); mx4.y = fmaxf(mx4.y, __shfl_xor(mx4.y, o)); mx4.z = fmaxf(mx4.z, __shfl_xor(mx4.z, o)); mx4.w = fmaxf(mx4.w, __shfl_xor(mx4.w, o)); }
    if (lane < 8) *(LAS f32x4*)(cm + wave * 32 + 4 * lane) = mx4;
    __syncthreads();
    f32x4 m8 = (f32x4){0.f, 0.f, 0.f, 0.f};
#pragma unroll
    for (int w = 0; w < 8; ++w) { const f32x4 c4 = *(const LAS f32x4*)(cm + w * 32 + 4 * cg); m8.x = fmaxf(m8.x, c4.x); m8.y = fmaxf(m8.y, c4.y); m8.z = fmaxf(m8.z, c4.z); m8.w = fmaxf(m8.w, c4.w); }
    if (wave == 0 && lane < 8) *(GAS f32x4*)(cs + drow0 + 4 * cg) = m8 * ((1.0f / 127.0f) * csmul);
    float inv[4] = {m8.x > 0.f ? 127.0f / m8.x : 0.f, m8.y > 0.f ? 127.0f / m8.y : 0.f, m8.z > 0.f ? 127.0f / m8.z : 0.f, m8.w > 0.f ? 127.0f / m8.w : 0.f};
#pragma unroll
    for (int e = 0; e < 4; ++e)
#pragma unroll
        for (int h = 0; h < 2; ++h) { const int b = 16 * h; v4u o;
            o.x = q8pack(wv[b + 0][e], wv[b + 1][e], wv[b + 2][e], wv[b + 3][e], inv[e]); o.y = q8pack(wv[b + 4][e], wv[b + 5][e], wv[b + 6][e], wv[b + 7][e], inv[e]);
            o.z = q8pack(wv[b + 8][e], wv[b + 9][e], wv[b + 10][e], wv[b + 11][e], inv[e]); o.w = q8pack(wv[b + 12][e], wv[b + 13][e], wv[b + 14][e], wv[b + 15][e], inv[e]);
            *(GAS v4u*)(W8 + (size_t)(drow0 + 4 * cg + e) * 2048 + kw + 32 * r8 + b) = o; }
    __syncthreads();
}

__device__ __forceinline__ void cast_row(const float* src, bf16* xb, float* rs, int lane, unsigned char* x8, float* rs8) {
    const GAS f32x4* xr = (const GAS f32x4*)src + lane; f32x4 v[8]; float ss = 0.f;
#pragma unroll
    for (int j = 0; j < 8; ++j) { v[j] = xr[64 * j]; ss += (v[j].x * v[j].x + v[j].y * v[j].y) + (v[j].z * v[j].z + v[j].w * v[j].w); }
    GAS v2u* o8 = (GAS v2u*)xb + lane;
#pragma unroll
    for (int j = 0; j < 8; ++j) { v2u o; o.x = pk2(v[j].x, v[j].y); o.y = pk2(v[j].z, v[j].w); o8[64 * j] = o; }
    const float r = 1.0f / sqrtf(wave_sum(ss) * (1.0f / DM) + RMS_EPS);
    if (lane == 0) *rs = r;
    if (x8) { float mx = 0.f;
#pragma unroll
        for (int j = 0; j < 8; ++j) mx = fmaxf(fmaxf(mx, fmaxf(fabsf(v[j].x), fabsf(v[j].y))), fmaxf(fabsf(v[j].z), fabsf(v[j].w)));
        mx = wave_max(mx); const float inv = mx > 0.f ? 127.0f / mx : 0.f; GAS unsigned* q = (GAS unsigned*)x8 + lane;
#pragma unroll
        for (int j = 0; j < 8; ++j) q[64 * j] = q8pack(v[j].x, v[j].y, v[j].z, v[j].w, inv);
        if (lane == 0) *rs8 = r * mx * (1.0f / 127.0f); }
}
__device__ __forceinline__ float sq8(const v4u w) { return (bf_lo(w.x) * bf_lo(w.x) + bf_hi(w.x) * bf_hi(w.x)) + (bf_lo(w.y) * bf_lo(w.y) + bf_hi(w.y) * bf_hi(w.y)) + (bf_lo(w.z) * bf_lo(w.z) + bf_hi(w.z) * bf_hi(w.z)) + (bf_lo(w.w) * bf_lo(w.w) + bf_hi(w.w) * bf_hi(w.w)); }
template <int R>
__device__ __forceinline__ void thin_rows(bf16* xb0, const bf16* f0, const float* gpost, float coef, float* rs0, float* xout0, int m0, int mstep, int mend, int lane, unsigned char* x8_0, float* rs8_0) {
    v4u xv[R][4], fv[R][4]; f32x4 g0[4], g1[4];
    const GAS f32x4* gp = (const GAS f32x4*)gpost + 2 * lane;
#pragma unroll
    for (int i = 0; i < R; ++i) { const int m = m0 + i * mstep; if (m < mend) { const GAS v4u* fr = (const GAS v4u*)(f0 + (size_t)m * DM) + lane; const GAS v4u* xr = (const GAS v4u*)(xb0 + (size_t)m * DM) + lane;
#pragma unroll
        for (int j = 0; j < 4; ++j) { fv[i][j] = fr[64 * j]; xv[i][j] = xr[64 * j]; } } }
#pragma unroll
    for (int j = 0; j < 4; ++j) { g0[j] = gp[128 * j]; g1[j] = gp[128 * j + 1]; }
    float ss[R];
#pragma unroll
    for (int i = 0; i < R; ++i) { ss[i] = 0.f; if (m0 + i * mstep < mend) {
#pragma unroll
        for (int j = 0; j < 4; ++j) ss[i] += sq8(fv[i][j]); } }
#pragma unroll
    for (int o = 1; o < 64; o <<= 1)
#pragma unroll
        for (int i = 0; i < R; ++i) ss[i] += __shfl_xor(ss[i], o);
    float s2[R], ymx[R], rr[R];
#pragma unroll
    for (int i = 0; i < R; ++i) { s2[i] = 0.f; ymx[i] = 0.f; rr[i] = 0.f; const int m = m0 + i * mstep; if (m < mend) { const float r = coef / sqrtf(ss[i] * (1.0f / DM) + RMS_EPS); rr[i] = r;
        GAS v4u* xr = (GAS v4u*)(xb0 + (size_t)m * DM) + lane;
#pragma unroll
        for (int j = 0; j < 4; ++j) { const v4u w = fv[i][j], x = xv[i][j];
            const float y0 = bf_lo(x.x) + bf_lo(w.x) * r * g0[j].x, y1 = bf_hi(x.x) + bf_hi(w.x) * r * g0[j].y, y2 = bf_lo(x.y) + bf_lo(w.y) * r * g0[j].z, y3 = bf_hi(x.y) + bf_hi(w.y) * r * g0[j].w;
            const float y4 = bf_lo(x.z) + bf_lo(w.z) * r * g1[j].x, y5 = bf_hi(x.z) + bf_hi(w.z) * r * g1[j].y, y6 = bf_lo(x.w) + bf_lo(w.w) * r * g1[j].z, y7 = bf_hi(x.w) + bf_hi(w.w) * r * g1[j].w;
            s2[i] += (y0 * y0 + y1 * y1) + (y2 * y2 + y3 * y3) + (y4 * y4 + y5 * y5) + (y6 * y6 + y7 * y7);
            ymx[i] = fmaxf(fmaxf(fmaxf(ymx[i], fmaxf(fabsf(y0), fabsf(y1))), fmaxf(fabsf(y2), fabsf(y3))), fmaxf(fmaxf(fabsf(y4), fabsf(y5)), fmaxf(fabsf(y6), fabsf(y7))));
            if (!xout0) { v4u o; o.x = pk2(y0, y1); o.y = pk2(y2, y3); o.z = pk2(y4, y5); o.w = pk2(y6, y7); xr[64 * j] = o; }
            if (xout0) { GAS f32x4* xo = (GAS f32x4*)(xout0 + (size_t)m * DM) + 2 * lane + 128 * j; xo[0] = (f32x4){y0, y1, y2, y3}; xo[1] = (f32x4){y4, y5, y6, y7}; } } } }
#pragma unroll
    for (int o = 1; o < 64; o <<= 1)
#pragma unroll
        for (int i = 0; i < R; ++i) s2[i] += __shfl_xor(s2[i], o);
#pragma unroll
    for (int i = 0; i < R; ++i) { const int m = m0 + i * mstep; if (m < mend && lane == 0 && !xout0) rs0[m] = 1.0f / sqrtf(s2[i] * (1.0f / DM) + RMS_EPS); }
    if (x8_0) {
#pragma unroll
        for (int o = 1; o < 64; o <<= 1)
#pragma unroll
            for (int i = 0; i < R; ++i) ymx[i] = fmaxf(ymx[i], __shfl_xor(ymx[i], o));
#pragma unroll
        for (int i = 0; i < R; ++i) { const int m = m0 + i * mstep; if (m < mend) { const float r = rr[i], inv = ymx[i] > 0.f ? 127.0f / ymx[i] : 0.f;
            GAS v2u* q = (GAS v2u*)(x8_0 + (size_t)m * DM) + lane;
#pragma unroll
            for (int j = 0; j < 4; ++j) { const v4u w = fv[i][j], x = xv[i][j];
                const float y0 = bf_lo(x.x) + bf_lo(w.x) * r * g0[j].x, y1 = bf_hi(x.x) + bf_hi(w.x) * r * g0[j].y, y2 = bf_lo(x.y) + bf_lo(w.y) * r * g0[j].z, y3 = bf_hi(x.y) + bf_hi(w.y) * r * g0[j].w;
                const float y4 = bf_lo(x.z) + bf_lo(w.z) * r * g1[j].x, y5 = bf_hi(x.z) + bf_hi(w.z) * r * g1[j].y, y6 = bf_lo(x.w) + bf_lo(w.w) * r * g1[j].z, y7 = bf_hi(x.w) + bf_hi(w.w) * r * g1[j].w;
                v2u o; o.x = q8pack(y0, y1, y2, y3, inv); o.y = q8pack(y4, y5, y6, y7, inv); q[64 * j] = o; }
            if (lane == 0) rs8_0[m] = ymx[i] * (1.0f / 127.0f) / sqrtf(s2[i] * (1.0f / DM) + RMS_EPS); } }
    }
}
__device__ __forceinline__ float slope_of(int h) { return exp2f(-8.0f * (float)(h + 1) / (float)NH); }
namespace att {
typedef short bf16x8 __attribute__((ext_vector_type(8)));
typedef short s16x4 __attribute__((ext_vector_type(4)));
typedef float f32x16 __attribute__((ext_vector_type(16)));
typedef unsigned u32x4 __attribute__((ext_vector_type(4)));
enum { MEM = 0, DIL = 1, OWN = 2, SPARSE = 3 };
constexpr float C_L2 = SCALE * 1.4426950408889634f;
constexpr int SHM_V = 16384, SHM_K = 16384;
constexpr int A_V = 0, A_K = 2 * SHM_V, A_WS = A_K + 2 * SHM_K, A_KM = A_WS + NWAVES * 256, A_END = A_KM + MOBA_NB * HD * 4;
constexpr int A_PRE = A_END, A_END2 = A_PRE + 2048;
static_assert(A_END2 <= RING_BYTES, "attention LDS");
#define KSWZ(row, colB) ((row) * 256 + ((colB) ^ (((row) & 7) << 4)))
#define SBAR() __builtin_amdgcn_sched_barrier(0)
__device__ __forceinline__ int crow(int r, int hi) { return (r & 3) + 8 * (r >> 2) + 4 * hi; }
__device__ __forceinline__ unsigned cvtpk(float lo, float hi) { unsigned r; asm volatile("v_cvt_pk_bf16_f32 %0, %1, %2" : "=v"(r) : "v"(lo), "v"(hi)); return r; }
__device__ __forceinline__ int v_st(int k, int c) { const int kk = (k & ~0xC) | ((k & 4) << 1) | ((k & 8) >> 1); return ((kk >> 3) * 4 + (c >> 5)) * 512 + ((kk & 7) * 32 + (c & 31)) * 2; }
__device__ __forceinline__ int v_rd_base(int lane) { return ((lane & 3) << 3) | (((lane >> 2) & 3) << 6) | (((lane >> 4) & 1) << 5) | (((lane >> 5) & 1) << 8); }
constexpr int v_rd_off(int d0, int ks, int half) { return d0 * 512 + ks * 4096 + half * 2048; }
template <int OFF> __device__ __forceinline__ s16x4 tr_read(int vb) { s16x4 r; asm volatile("ds_read_b64_tr_b16 %0, %1 offset:%2" : "=&v"(r) : "v"(vb), "i"(OFF) : "memory"); return r; }
template <int D0> __device__ __forceinline__ void pv_one(f32x16& od, int vb, bf16x8 pa0, bf16x8 pa1, bf16x8 pa2, bf16x8 pa3) {
  const s16x4 l0 = tr_read<v_rd_off(D0, 0, 0)>(vb), h0 = tr_read<v_rd_off(D0, 0, 1)>(vb), l1 = tr_read<v_rd_off(D0, 1, 0)>(vb), h1 = tr_read<v_rd_off(D0, 1, 1)>(vb);
  const s16x4 l2 = tr_read<v_rd_off(D0, 2, 0)>(vb), h2 = tr_read<v_rd_off(D0, 2, 1)>(vb), l3 = tr_read<v_rd_off(D0, 3, 0)>(vb), h3 = tr_read<v_rd_off(D0, 3, 1)>(vb);
  asm volatile("s_waitcnt lgkmcnt(0)" ::: "memory"); SBAR();
#define PKV(L, H) (bf16x8){L[0], L[1], L[2], L[3], H[0], H[1], H[2], H[3]}
  od = __builtin_amdgcn_mfma_f32_32x32x16_bf16(PKV(l0, h0), pa0, od, 0, 0, 0);
  od = __builtin_amdgcn_mfma_f32_32x32x16_bf16(PKV(l1, h1), pa1, od, 0, 0, 0);
  od = __builtin_amdgcn_mfma_f32_32x32x16_bf16(PKV(l2, h2), pa2, od, 0, 0, 0);
  od = __builtin_amdgcn_mfma_f32_32x32x16_bf16(PKV(l3, h3), pa3, od, 0, 0, 0);
#undef PKV
}
__device__ __forceinline__ void store_row_t21(const f32x16 (&o)[4], float rl, bf16* orow, int hi) {
#pragma unroll
  for (int d0 = 0; d0 < 4; ++d0)
#pragma unroll
    for (int k = 0; k < 4; k += 2) {
      unsigned ax = cvtpk(o[d0][4 * k + 0] * rl, o[d0][4 * k + 1] * rl), ay = cvtpk(o[d0][4 * k + 2] * rl, o[d0][4 * k + 3] * rl);
      unsigned bx = cvtpk(o[d0][4 * k + 4] * rl, o[d0][4 * k + 5] * rl), by = cvtpk(o[d0][4 * k + 6] * rl, o[d0][4 * k + 7] * rl);
      { auto r = __builtin_amdgcn_permlane32_swap(ax, bx, false, false); ax = r[0]; bx = r[1]; }
      { auto r = __builtin_amdgcn_permlane32_swap(ay, by, false, false); ay = r[0]; by = r[1]; }
      *(u32x4*)(orow + d0 * 32 + 8 * k + (hi ? 8 : 0)) = (u32x4){ax, ay, bx, by}; }
}
__device__ __forceinline__ void qkt(f32x16& p0, f32x16& p1, const LAS char* Ks, const bf16x8 (&qr)[8], int r32, int hi) {
  p0 = f32x16{}; p1 = f32x16{};
#pragma unroll
  for (int d0 = 0; d0 < 8; ++d0) { const int cb = (d0 * 16 + hi * 8) * 2;
    const bf16x8 b0 = *(const LAS bf16x8*)(Ks + KSWZ(r32, cb));
    const bf16x8 b1 = *(const LAS bf16x8*)(Ks + KSWZ(32 + r32, cb));
    p0 = __builtin_amdgcn_mfma_f32_32x32x16_bf16(b0, qr[d0], p0, 0, 0, 0);
    p1 = __builtin_amdgcn_mfma_f32_32x32x16_bf16(b1, qr[d0], p1, 0, 0, 0); }
}
struct UnitDesc {
    int qrow0, qstride;
    int qcol, kcol, vcol, ocol;
    int qidx0;
    int kidx0, krow0, kstride;
    int t_begin, t_end;
    float cbr;
    int h;
};
template <int MODE>
__device__ __forceinline__ void attn_unit(const UnitDesc& u, const bf16* P, bf16* O, float* lse_out, LAS char* lds) {
  int tid_ = threadIdx.x; asm volatile("" : "+v"(tid_));
  const int tid = tid_, wid = __builtin_amdgcn_readfirstlane(tid >> 6), lane = tid & 63, r32 = lane & 31, hi = lane >> 5;
  LAS char* V_lds = lds + A_V; LAS char* K_lds = lds + A_K;
  const int qi = wid * 32 + r32;
  const LAS int* rows_l = (const LAS int*)(lds + A_KM); const LAS int* dst_l = rows_l + 256;
  const int qtok = (MODE == SPARSE) ? rows_l[qi] : u.qrow0 + qi * u.qstride;
  const int qidx = (MODE == SPARSE) ? qtok : u.qidx0 + qi;
  bf16x8 qr[8];
  { const bf16* Qw = P + (size_t)qtok * LDP + u.qcol + hi * 8;
#pragma unroll
    for (int d0 = 0; d0 < 8; ++d0) qr[d0] = *(const GAS bf16x8*)(Qw + d0 * 16); }
  const float dhi_c = (MODE == DIL) ? (float)(qidx < 128 ? qidx : 128) : 1e30f;
  const int sr = tid >> 4, sc = (tid & 15) * 8, vst0 = v_st(sr, sc), vst1 = v_st(32 + sr, sc);
  const int vb0 = (int)(unsigned)(size_t)V_lds + v_rd_base(lane);
  bf16x8 vs0, vs1, ks0, ks1;
#define SLOAD(t) do { int i0_ = u.kidx0 + 64 * (t) + sr, i1_ = i0_ + 32; if (MODE == DIL) { i0_ = i0_ < 0 ? 0 : i0_; i1_ = i1_ < 0 ? 0 : i1_; } \
    const bf16* r0_ = P + (size_t)(u.krow0 + i0_ * u.kstride) * LDP + sc; const bf16* r1_ = P + (size_t)(u.krow0 + i1_ * u.kstride) * LDP + sc; \
    ks0 = *(const GAS bf16x8*)(r0_ + u.kcol); vs0 = *(const GAS bf16x8*)(r0_ + u.vcol); ks1 = *(const GAS bf16x8*)(r1_ + u.kcol); vs1 = *(const GAS bf16x8*)(r1_ + u.vcol); } while (0)
#define SWRITE(b) do { *(LAS bf16x8*)(V_lds + (b) * SHM_V + vst0) = vs0; *(LAS bf16x8*)(V_lds + (b) * SHM_V + vst1) = vs1; \
    *(LAS bf16x8*)(K_lds + (b) * SHM_K + KSWZ(sr, sc * 2)) = ks0; *(LAS bf16x8*)(K_lds + (b) * SHM_K + KSWZ(32 + sr, sc * 2)) = ks1; } while (0)
  float m_reg = -1e30f, l_reg = 0.f; f32x16 o[4] = {};
  SLOAD(u.t_begin);
  for (int t = u.t_begin; t < u.t_end; ++t) {
    const int b = (t - u.t_begin) & 1;
    SWRITE(b);
    __syncthreads();
    if (t + 1 < u.t_end) SLOAD(t + 1);
    bool active = true; float dhi = dhi_c;
    if constexpr (MODE == DIL) { const int tlo = wid >> 1; active = (t >= tlo) && (t <= tlo + 2); }
    if constexpr (MODE == OWN) active = (t - u.t_begin) <= (wid >> 1);
    if (active) {
      f32x16 p0, p1; qkt(p0, p1, K_lds + b * SHM_K, qr, r32, hi);
      if constexpr (MODE == SPARSE) {
        const float bf = (float)(qidx - u.kidx0 - 64 * t - 4 * hi), ncb = -u.cbr;
#pragma unroll
        for (int r = 0; r < 16; ++r) { const float d0 = bf - (float)((r & 3) + 8 * (r >> 2)); p0[r] = fmaf(ncb, d0, p0[r]); p1[r] = fmaf(ncb, d0 - 32.f, p1[r]); }
      } else if constexpr (MODE != MEM) {
        const float bf = (float)(qidx - u.kidx0 - 64 * t - 4 * hi), ncb = -u.cbr;
#pragma unroll
        for (int r = 0; r < 16; ++r) { const float d0 = bf - (float)((r & 3) + 8 * (r >> 2)), d1 = d0 - 32.f;
          p0[r] = (d0 >= 0.f && d0 <= dhi) ? fmaf(ncb, d0, p0[r]) : -1e30f;
          p1[r] = (d1 >= 0.f && d1 <= dhi) ? fmaf(ncb, d1, p1[r]) : -1e30f; }
      }
      float pmax = p0[0];
#pragma unroll
      for (int r = 1; r < 16; ++r) pmax = fmaxf(pmax, p0[r]);
#pragma unroll
      for (int r = 0; r < 16; ++r) pmax = fmaxf(pmax, p1[r]);
      { auto rr = __builtin_amdgcn_permlane32_swap(__float_as_uint(pmax), __float_as_uint(pmax), false, false); pmax = fmaxf(__uint_as_float(rr[0]), __uint_as_float(rr[1])); }
      const float mn = fmaxf(m_reg, pmax), alpha = __builtin_amdgcn_exp2f((m_reg - mn) * C_L2); m_reg = mn;
      const float mnC = -mn * C_L2;
#pragma unroll
      for (int r = 0; r < 16; ++r) { p0[r] = __builtin_amdgcn_exp2f(fmaf(p0[r], C_L2, mnC)); p1[r] = __builtin_amdgcn_exp2f(fmaf(p1[r], C_L2, mnC)); }
      float ps = 0.f;
#pragma unroll
      for (int r = 0; r < 16; ++r) ps += p0[r];
#pragma unroll
      for (int r = 0; r < 16; ++r) ps += p1[r];
      { auto rr = __builtin_amdgcn_permlane32_swap(__float_as_uint(ps), __float_as_uint(ps), false, false); ps = __uint_as_float(rr[0]) + __uint_as_float(rr[1]); }
      l_reg = l_reg * alpha + ps;
      bf16x8 pa0, pa1, pa2, pa3;
#define PK4(Pv, BASE, OUT) do { unsigned a0 = cvtpk(Pv[BASE + 0], Pv[BASE + 1]), a1 = cvtpk(Pv[BASE + 2], Pv[BASE + 3]);   \
    unsigned b0 = cvtpk(Pv[BASE + 4], Pv[BASE + 5]), b1 = cvtpk(Pv[BASE + 6], Pv[BASE + 7]);                              \
    auto r0 = __builtin_amdgcn_permlane32_swap(a0, b0, false, false); auto r1 = __builtin_amdgcn_permlane32_swap(a1, b1, false, false); \
    u32x4 w = {r0[0], r1[0], r0[1], r1[1]}; OUT = *reinterpret_cast<bf16x8*>(&w); } while (0)
      PK4(p0, 0, pa0); PK4(p0, 8, pa1); PK4(p1, 0, pa2); PK4(p1, 8, pa3);
#undef PK4
      if (__any(alpha < 1.f)) {
#pragma unroll
        for (int d = 0; d < 4; ++d) o[d] *= alpha; }
      const int vb = vb0 + b * SHM_V;
      pv_one<0>(o[0], vb, pa0, pa1, pa2, pa3); pv_one<1>(o[1], vb, pa0, pa1, pa2, pa3); pv_one<2>(o[2], vb, pa0, pa1, pa2, pa3); pv_one<3>(o[3], vb, pa0, pa1, pa2, pa3);
    }
  }
#undef SLOAD
#undef SWRITE
  { long ob;
    if constexpr (MODE == SPARSE) ob = (long)dst_l[qi] * HD;
    else if constexpr (MODE == OWN) ob = ((long)(qtok * NH + u.h) * 4 + 3) * HD;
    else ob = (long)qtok * DM + u.ocol;
    if (MODE != SPARSE || ob >= 0) store_row_t21(o, 1.0f / l_reg, O + ob, hi); }
  if (hi == 0) { const float lv = m_reg * SCALE + __logf(l_reg);
    if constexpr (MODE == DIL) lse_out[(size_t)qtok * NH + u.h] = lv;
    if constexpr (MODE == OWN) lse_out[((size_t)qtok * NH + u.h) * 4 + 3] = lv;
    if constexpr (MODE == SPARSE) { const int dd = dst_l[qi]; if (dd >= 0) lse_out[dd] = lv; } }
  asm volatile("s_waitcnt lgkmcnt(0)" ::: "memory");
  __syncthreads();
}
constexpr int B_V = 0, B_K = 65536, B_WS = RING_BYTES + 4096, B_PRE = RING_BYTES + 8192;
template <int BMODE>
__device__ __forceinline__ void block_unit(int h, int n, int g0, int g1, int cntv, const int* lst, const unsigned* selm_h, const bf16* P, bf16* O, float* lse_out, LAS char* lds, float cbr) {
  int tid_ = threadIdx.x; asm volatile("" : "+v"(tid_));
  const int tid = tid_, wid = __builtin_amdgcn_readfirstlane(tid >> 6), lane = tid & 63, r32 = lane & 31, hi = lane >> 5;
  LAS char* V_lds = lds + B_V; LAS char* K_lds = lds + B_K;
  const int krow0 = BMODE == 0 ? n * MOBA_BLK : SEQ, kcol = BMODE == 0 ? KCOL + h * HD : KMCOL + h * HD, vcol = BMODE == 0 ? VCOL + h * HD : VMCOL + h * HD, qcol = BMODE == 0 ? QCOL + h * HD : QMCOL + h * HD;
  { const int sr = tid >> 4, sc = (tid & 15) * 8; bf16x8 kq[4][2], vq[4][2];
#pragma unroll
    for (int t = 0; t < 4; ++t)
#pragma unroll
      for (int q = 0; q < 2; ++q) { const bf16* rp = P + (size_t)(krow0 + 64 * t + 32 * q + sr) * LDP + sc; kq[t][q] = __builtin_nontemporal_load((const GAS bf16x8*)(rp + kcol)); vq[t][q] = __builtin_nontemporal_load((const GAS bf16x8*)(rp + vcol)); }
#pragma unroll
    for (int t = 0; t < 4; ++t)
#pragma unroll
      for (int q = 0; q < 2; ++q) { *(LAS bf16x8*)(K_lds + t * SHM_K + KSWZ(32 * q + sr, sc * 2)) = kq[t][q]; *(LAS bf16x8*)(V_lds + t * SHM_V + v_st(32 * q + sr, sc)) = vq[t][q]; } }
  __syncthreads();
  const int vb0 = (int)(unsigned)(size_t)V_lds + v_rd_base(lane);
#define BU_ROWINFO(gg, TOK, DST) do { if constexpr (BMODE == 1) { TOK = 32 * (gg) + r32; DST = 0; } \
    else { if ((gg) < 8) { TOK = n * MOBA_BLK + 32 * (gg) + r32; DST = (TOK * NH + h) * 4 + 3; } \
           else { const int idx_ = 32 * ((gg) - 8) + r32; const bool valid_ = idx_ < cntv; TOK = lst[valid_ ? idx_ : 0]; const unsigned sm_ = selm_h[TOK]; DST = valid_ ? (TOK * NH + h) * 4 + __popc(sm_ & ((1u << n) - 1u)) : -1; } } } while (0)
#define BU_QLOAD(QR, TOK) do { const bf16* Qw_ = P + (size_t)(TOK) * LDP + qcol + hi * 8; _Pragma("unroll") for (int d0_ = 0; d0_ < 8; ++d0_) QR[d0_] = *(const GAS bf16x8*)(Qw_ + d0_ * 16); } while (0)
  int g = g0 + wid;
  if (g < g1) {
  int qtok, dst;
  BU_ROWINFO(g, qtok, dst);
  for (;;) {
    const int gn = g + NWAVES;
    bf16x8 qr[8]; BU_QLOAD(qr, qtok);
    int tok1 = 0, dst1 = -1;
    if (gn < g1) BU_ROWINFO(gn, tok1, dst1);
    asm volatile("" ::: "memory");
    const bool own = BMODE == 0 && g < 8;
    float m_reg = -1e30f, l_reg = 0.f; f32x16 o[4] = {};
    const int tmax = own ? (g >> 1) : 3;
    auto softmax_tile = [&](const int t, f32x16& p0, f32x16& p1, bf16x8& pa0, bf16x8& pa1, bf16x8& pa2, bf16x8& pa3) -> float {
      if constexpr (BMODE == 0) {
        const float bf = (float)(qtok - n * MOBA_BLK - 64 * t - 4 * hi), ncb = -cbr;
        if (own) {
#pragma unroll
          for (int r = 0; r < 16; ++r) { const float d0 = bf - (float)((r & 3) + 8 * (r >> 2)), d1 = d0 - 32.f;
            p0[r] = d0 >= 0.f ? fmaf(ncb, d0, p0[r]) : -1e30f; p1[r] = d1 >= 0.f ? fmaf(ncb, d1, p1[r]) : -1e30f; }
        } else {
#pragma unroll
          for (int r = 0; r < 16; ++r) { const float d0 = bf - (float)((r & 3) + 8 * (r >> 2)); p0[r] = fmaf(ncb, d0, p0[r]); p1[r] = fmaf(ncb, d0 - 32.f, p1[r]); }
        }
      }
      float pmax = p0[0];
#pragma unroll
      for (int r = 1; r < 16; ++r) pmax = fmaxf(pmax, p0[r]);
#pragma unroll
      for (int r = 0; r < 16; ++r) pmax = fmaxf(pmax, p1[r]);
      { auto rr = __builtin_amdgcn_permlane32_swap(__float_as_uint(pmax), __float_as_uint(pmax), false, false); pmax = fmaxf(__uint_as_float(rr[0]), __uint_as_float(rr[1])); }
      const float mn = fmaxf(m_reg, pmax), alpha = __builtin_amdgcn_exp2f((m_reg - mn) * C_L2); m_reg = mn;
      const float mnC = -mn * C_L2;
#pragma unroll
      for (int r = 0; r < 16; ++r) { p0[r] = __builtin_amdgcn_exp2f(fmaf(p0[r], C_L2, mnC)); p1[r] = __builtin_amdgcn_exp2f(fmaf(p1[r], C_L2, mnC)); }
      float ps = 0.f;
#pragma unroll
      for (int r = 0; r < 16; ++r) ps += p0[r];
#pragma unroll
      for (int r = 0; r < 16; ++r) ps += p1[r];
      { auto rr = __builtin_amdgcn_permlane32_swap(__float_as_uint(ps), __float_as_uint(ps), false, false); ps = __uint_as_float(rr[0]) + __uint_as_float(rr[1]); }
      l_reg = l_reg * alpha + ps;
#define PK4(Pv, BASE, OUT) do { unsigned a0 = cvtpk(Pv[BASE + 0], Pv[BASE + 1]), a1 = cvtpk(Pv[BASE + 2], Pv[BASE + 3]);   \
    unsigned b0 = cvtpk(Pv[BASE + 4], Pv[BASE + 5]), b1 = cvtpk(Pv[BASE + 6], Pv[BASE + 7]);                              \
    auto r0 = __builtin_amdgcn_permlane32_swap(a0, b0, false, false); auto r1 = __builtin_amdgcn_permlane32_swap(a1, b1, false, false); \
    u32x4 w = {r0[0], r1[0], r0[1], r1[1]}; OUT = *reinterpret_cast<bf16x8*>(&w); } while (0)
      PK4(p0, 0, pa0); PK4(p0, 8, pa1); PK4(p1, 0, pa2); PK4(p1, 8, pa3);
#undef PK4
      return alpha; };
    bf16x8 qa0, qa1, qa2, qa3;
    { f32x16 p0, p1; qkt(p0, p1, K_lds, qr, r32, hi); (void)softmax_tile(0, p0, p1, qa0, qa1, qa2, qa3); }
    for (int t = 1; t <= tmax; ++t) {
      f32x16 p0, p1; qkt(p0, p1, K_lds + t * SHM_K, qr, r32, hi);
      { const int vb = vb0 + (t - 1) * SHM_V; pv_one<0>(o[0], vb, qa0, qa1, qa2, qa3); pv_one<1>(o[1], vb, qa0, qa1, qa2, qa3); pv_one<2>(o[2], vb, qa0, qa1, qa2, qa3); pv_one<3>(o[3], vb, qa0, qa1, qa2, qa3); }
      bf16x8 pa0, pa1, pa2, pa3; const float alpha = softmax_tile(t, p0, p1, pa0, pa1, pa2, pa3);
      if (__any(alpha < 1.f)) {
#pragma unroll
        for (int d = 0; d < 4; ++d) o[d] *= alpha; }
      qa0 = pa0; qa1 = pa1; qa2 = pa2; qa3 = pa3;
    }
    { const int vb = vb0 + tmax * SHM_V; pv_one<0>(o[0], vb, qa0, qa1, qa2, qa3); pv_one<1>(o[1], vb, qa0, qa1, qa2, qa3); pv_one<2>(o[2], vb, qa0, qa1, qa2, qa3); pv_one<3>(o[3], vb, qa0, qa1, qa2, qa3); }
    { const long ob = BMODE == 1 ? (long)qtok * DM + SELF_W + h * HD : (long)dst * HD;
      if (BMODE == 1 || dst >= 0) store_row_t21(o, 1.0f / l_reg, O + ob, hi); }
    if constexpr (BMODE == 0) { if (hi == 0 && dst >= 0) lse_out[dst] = m_reg * SCALE + __logf(l_reg); }
    if (gn >= g1) break;
    qtok = tok1; dst = dst1; g = gn;
  }
  }
#undef BU_ROWINFO
#undef BU_QLOAD
  __syncthreads();
}
__device__ __forceinline__ void gate_unit(int h, int qb, const bf16* P, const float* kmean, unsigned* selmask_out, float* plse, unsigned* cnt, int* list, LAS char* lds) {
  int tid_ = threadIdx.x; asm volatile("" : "+v"(tid_));
  const int tid = tid_, wid = __builtin_amdgcn_readfirstlane(tid >> 6), lane = tid & 63, r32 = lane & 31, hi = lane >> 5;
  const int srow = qb * MOBA_BLK + wid * 32 + r32;
  unsigned selmask = 0u;
  if (qb > 0) {
    LAS float* km = (LAS float*)(lds + A_KM);
    for (int i = tid; i < qb * HD; i += NWAVES * 64) km[i] = kmean[(size_t)h * MOBA_NB * HD + i];
    bf16x8 qr[8];
    { const bf16* Qw = P + (size_t)srow * LDP + QCOL + h * HD + hi * 8;
#pragma unroll
      for (int d0 = 0; d0 < 8; ++d0) qr[d0] = *(const GAS bf16x8*)(Qw + d0 * 16); }
    __syncthreads();
    float qf[64];
#pragma unroll
    for (int d0 = 0; d0 < 8; ++d0)
#pragma unroll
      for (int j = 0; j < 8; ++j) qf[d0 * 8 + j] = __uint_as_float(((unsigned)(unsigned short)qr[d0][j]) << 16);
    float b1 = -INFINITY, b2 = -INFINITY, b3 = -INFINITY; int i1 = -1, i2 = -1, i3 = -1;
    for (int n = 0; n < qb; ++n) {
      const LAS float* kr = km + n * HD + hi * 8; float a = 0.f;
#pragma unroll
      for (int d0 = 0; d0 < 8; ++d0) { const f32x4 k0 = *(const LAS f32x4*)(kr + d0 * 16), k1 = *(const LAS f32x4*)(kr + d0 * 16 + 4);
        a += qf[d0 * 8 + 0] * k0.x + qf[d0 * 8 + 1] * k0.y + qf[d0 * 8 + 2] * k0.z + qf[d0 * 8 + 3] * k0.w + qf[d0 * 8 + 4] * k1.x + qf[d0 * 8 + 5] * k1.y + qf[d0 * 8 + 6] * k1.z + qf[d0 * 8 + 7] * k1.w; }
      a += __shfl_xor(a, 32);
      if (a > b1) { b3 = b2; i3 = i2; b2 = b1; i2 = i1; b1 = a; i1 = n; } else if (a > b2) { b3 = b2; i3 = i2; b2 = a; i2 = n; } else if (a > b3) { b3 = a; i3 = n; }
    }
    selmask = (i1 >= 0 ? 1u << i1 : 0u) | (i2 >= 0 ? 1u << i2 : 0u) | (i3 >= 0 ? 1u << i3 : 0u);
  }
  LAS int* sm_l = (LAS int*)(lds + A_V); LAS int* cw = sm_l + 256; LAS int* cwpre = cw + 256; LAS int* base_l = cwpre + 256; LAS int* posl = base_l + 32;
  if (hi == 0) { selmask_out[(size_t)h * SEQ + srow] = selmask; const int ns = __popc(selmask); sm_l[wid * 32 + r32] = (int)selmask;
    float* pl = plse + ((size_t)srow * NH + h) * 4;
    if (ns < 1) pl[0] = -INFINITY; if (ns < 2) pl[1] = -INFINITY; if (ns < 3) pl[2] = -INFINITY; }
  __syncthreads();
  if (tid < 256) { const int n = tid & 31, w = tid >> 5; int c = 0;
    for (int r = 0; r < 32; ++r) { const unsigned sm = (unsigned)sm_l[w * 32 + r]; if ((sm >> n) & 1u) { posl[(w * 32 + r) * 4 + __popc(sm & ((1u << n) - 1u))] = c; ++c; } }
    cw[n * 8 + w] = c; }
  __syncthreads();
  if (tid < 32) { int tot = 0;
#pragma unroll
    for (int w = 0; w < 8; ++w) { cwpre[tid * 8 + w] = tot; tot += cw[tid * 8 + w]; }
    base_l[tid] = tot > 0 ? (int)__hip_atomic_fetch_add(cnt + h * MOBA_NB + tid, (unsigned)tot, __ATOMIC_RELAXED, __HIP_MEMORY_SCOPE_AGENT) : 0; }
  __syncthreads();
  if (hi == 0) { unsigned sm = selmask; const int row = wid * 32 + r32;
    while (sm) { const int n = __ffs((int)sm) - 1; const int slot = __popc(selmask & ((1u << n) - 1u));
      list[(size_t)(h * MOBA_NB + n) * SEQ + base_l[n] + cwpre[n * 8 + wid] + posl[row * 4 + slot]] = srow; sm &= sm - 1u; } }
  __syncthreads();
}
#undef KSWZ
#undef SBAR
}

struct Args { const float* in[10]; float* out; unsigned char* ws; };
__global__ void __launch_bounds__(NWAVES * 64, 2) trunk_fwd(Args args) {
    extern __shared__ __attribute__((aligned(16))) unsigned char lds_raw[];
    Ctx F;
    F.lds = (LAS unsigned char*)lds_raw;
    volatile LAS unsigned* MISC = (volatile LAS unsigned*)(F.lds + MISC_OFF);
    F.tid = threadIdx.x; F.lane = F.tid & 63; F.wave = __builtin_amdgcn_readfirstlane(F.tid >> 6);
    F.G = gridDim.x; { const int bx = blockIdx.x; F.vcu = (F.G % 8 == 0) ? (bx % 8) * (F.G / 8) + bx / 8 : bx; }
    unsigned char* ws = args.ws;
    unsigned* ctl = (unsigned*)(ws + WS_CTL);
    for (int u = F.tid; u < (LDS_BYTES - LDSCTL_OFF) / 4; u += NWAVES * 64) ((LAS unsigned*)(F.lds + LDSCTL_OFF))[u] = 0u;
    __syncthreads();
    XcdBarrier bar = xcd_barrier_post(ctl + CW_BAR, MISC + 8);
#define GRID_BAR() xcd_barrier(bar)

    const float* x_in = args.in[0]; const float* mem = args.in[1]; const float* g_pre = args.in[2]; const float* g_post = args.in[3]; const float* g_mem = args.in[4];
    const float* w_ffn_in = args.in[5]; const float* w_ffn_out = args.in[6]; const float* w_in = args.in[7]; const float* w_mem_kv = args.in[8]; const float* w_out = args.in[9];
    float* X = args.out;
    unsigned char* Cat8 = ws + WS_A; float* cat_rs = (float*)(ws + WS_RSTD + 128 * 1024);     bf16* Hb = (bf16*)(ws + WS_H); unsigned char* H8 = ws + WS_F + 32 * MiB; float* rs8 = (float*)(ws + WS_RSTD + 64 * 1024);     bf16* Ab = (bf16*)(ws + WS_A); bf16* Fb = (bf16*)(ws + WS_F); float* rstd = (float*)(ws + WS_RSTD); bf16* Pb = (bf16*)(ws + WS_P); bf16* Cat = (bf16*)(ws + WS_CAT);
    float* kmean = (float*)(ws + WS_KMEAN);
#define PHASE_BEGIN() int tid_ = threadIdx.x; asm volatile("" : "+v"(tid_)); int bx_ = blockIdx.x, G_ = gridDim.x; asm volatile("" : "+s"(bx_), "+s"(G_)); \
    const int lane = tid_ & 63, wave = __builtin_amdgcn_readfirstlane(tid_ >> 6), vcu = (G_ % 8 == 0) ? (bx_ % 8) * (G_ / 8) + bx_ / 8 : bx_, gw = vcu * NWAVES + wave, NGW = G_ * NWAVES; (void)lane; (void)gw; (void)NGW

    constexpr int I_IN = (DM / 64) * (2 * DFF / 32), I_OUT = (DFF / 64) * (DM / 32), I_QKV = (DM / 64) * (IN_W / 32), I_MKV = (DM / 64) * (KVW / 32), I_O = (DM / 64) * (DM / 32);
    constexpr int I_LAYER = 2 * I_IN + 2 * I_OUT + I_QKV + I_MKV + I_O;
#ifndef TAIL_FILL
#define TAIL_FILL 1
#endif
#ifndef TAIL_FRAC
#define TAIL_FRAC 256
#endif
    constexpr int P0_LAYERS = TAIL_FILL ? 1 : DEPTH;
#define CONVERT_ITEM(l_, r_) do { const int cl_ = (l_); int cr_ = (r_); unsigned char* cw_ = ws + WS_W + (size_t)cl_ * LW; \
        if (cr_ < 2 * I_IN) { } \
        else if ((cr_ -= 2 * I_IN) < 2 * I_OUT) { const int half = cr_ / I_OUT; cr_ %= I_OUT; const int nblk = DM / 32, k0 = 64 * (cr_ / nblk), n0 = 32 * (cr_ % nblk); \
            p0_transpose_item(w_ffn_out + (size_t)(cl_ * 2 + half) * DFF * DM, DFF, DM, (bf16*)(cw_ + LW_OUT + (size_t)half * 22 * MiB), k0, n0, n0, scr, lane, nullptr); } \
        else if ((cr_ -= 2 * I_OUT) < I_QKV) { const int nblk = IN_W / 32, k0 = 64 * (cr_ / nblk), n0 = 32 * (cr_ % nblk); \
            p0_transpose_item(w_in + (size_t)cl_ * DM * IN_W, DM, IN_W, (bf16*)(cw_ + LW_QKV), k0, n0, n0, scr, lane, g_pre + (size_t)(cl_ * 3 + 1) * DM); } \
        else if ((cr_ -= I_QKV) < I_MKV) { const int nblk = KVW / 32, k0 = 64 * (cr_ / nblk), n0 = 32 * (cr_ % nblk); \
            p0_transpose_item(w_mem_kv + (size_t)cl_ * DM * KVW, DM, KVW, (bf16*)(cw_ + LW_QKV), k0, n0, IN_W + n0, scr, lane, g_mem + (size_t)cl_ * DM); } \
        else { cr_ -= I_MKV; const int nblk = DM / 32, k0 = 64 * (cr_ / nblk), n0 = 32 * (cr_ % nblk); \
            p0_transpose_item(w_out + (size_t)cl_ * DM * DM, DM, DM, (bf16*)(cw_ + LW_O), k0, n0, n0, scr, lane, nullptr); } } while (0)
    constexpr int C_SPLIT = 2816;
    constexpr int N_STRIP = 2 * DFF / 32, S_SPLIT = C_SPLIT / 32;
#define CONVERT_STRIP(l_, half_, s_) do { const int cl_ = (l_), ch_ = (half_), n0 = 32 * (s_); unsigned char* cw_ = ws + WS_W + (size_t)cl_ * LW + LW_IN + (size_t)ch_ * 44 * MiB; \
        const int j = n0 < DFF ? n0 : n0 - DFF; const int drow = 256 * (j / 128) + (n0 < DFF ? 0 : 128) + (j % 128); \
        strip_convert8(w_ffn_in + (size_t)(cl_ * 2 + ch_) * DM * 2 * DFF, 2 * DFF, g_pre + (size_t)(cl_ * 3 + 2 * ch_) * DM, cw_, (float*)(cw_ + 32 * MiB), n0, drow, scr, (LAS float*)(F.lds + CMAX_OFF), wave, lane, n0 < DFF ? 1.4426950408889634f : 0.6931471805599453f); } while (0)
    constexpr int NQ_STRIP = IN_W / 32, NQ_ALL = LDP / 32;
#define CONVERT_QSTRIP(l_, s_) do { const int cl_ = (l_), cs_ = (s_); unsigned char* cw_ = ws + WS_W + (size_t)cl_ * LW + LW_QKV; \
        if (cs_ < NQ_STRIP) strip_convert8(w_in + (size_t)cl_ * DM * IN_W, IN_W, g_pre + (size_t)(cl_ * 3 + 1) * DM, cw_, (float*)(cw_ + 16 * MiB), 32 * cs_, 32 * cs_, scr, (LAS float*)(F.lds + CMAX_OFF), wave, lane); \
        else strip_convert8(w_mem_kv + (size_t)cl_ * DM * KVW, KVW, g_mem + (size_t)cl_ * DM, cw_, (float*)(cw_ + 16 * MiB), 32 * (cs_ - NQ_STRIP), 32 * cs_, scr, (LAS float*)(F.lds + CMAX_OFF), wave, lane); } while (0)
#define CONVERT_OSTRIP(l_, s_) do { const int cl_ = (l_); unsigned char* cw_ = ws + WS_W + (size_t)cl_ * LW + LW_O; \
        strip_convert8(w_out + (size_t)cl_ * DM * DM, DM, nullptr, cw_, (float*)(cw_ + 6 * MiB), 32 * (s_), 32 * (s_), scr, (LAS float*)(F.lds + CMAX_OFF), wave, lane); } while (0)
#define QSTRIP_RANGE(lay_) do { for (int st = bx_ - fi_; st < NQ_ALL + DM / 32; st += G_ - fi_) { if (st < NQ_ALL) CONVERT_QSTRIP((lay_), st); else CONVERT_OSTRIP((lay_), st - NQ_ALL); } } while (0)
#define QSTRIP_RANGE_OLD(lay_) do { for (int st = bx_ - fi_; st < NQ_ALL; st += G_ - fi_) CONVERT_QSTRIP((lay_), st); } while (0)
#define STRIP_RANGE(lay_, half_, a_, b_) do { for (int st = (a_) + (bx_ - fi_); st < (b_); st += G_ - fi_) CONVERT_STRIP((lay_), (half_), st); } while (0)
#define CONV_RANGE(lay_, a_, b_) do { for (int it = (a_) + w0_; it < (b_); it += nw_) CONVERT_ITEM((lay_), it); } while (0)
#ifndef TAIL_SHARE
#define TAIL_SHARE 197
#endif
#define TAIL_STRIP(l_, tail_, i_) do { const int ti_ = (i_); \
        if ((tail_) == 0) { if (ti_ < NQ_ALL) CONVERT_QSTRIP((l_), ti_); else CONVERT_OSTRIP((l_), ti_ - NQ_ALL); } \
        else if ((tail_) == 1) { if (ti_ < N_STRIP) CONVERT_STRIP((l_), 1, ti_); else CONVERT_STRIP((l_) + 1, 0, ti_ - N_STRIP); } \
        else CONVERT_STRIP((l_) + 1, 0, S_SPLIT + ti_); } while (0)
#define TAIL_CONVERT(l_, tail_, first_idle_) do { if (TAIL_FILL) { PHASE_BEGIN(); const int fi_ = (first_idle_); const bool conv_ = bx_ >= fi_; \
        const int cwi_ = conv_ ? bx_ - fi_ : bx_, cwn_ = conv_ ? G_ - fi_ : fi_; \
        LAS float* scr = (LAS float*)(F.lds + RING_OFF + wave * 16384); const int nw_ = cwn_ * NWAVES, w0_ = cwi_ * NWAVES + wave; \
        const bool nxt_ = (l_) + 1 < DEPTH; \
        const int nS_ = (tail_) == 0 ? NQ_ALL + DM / 32 : ((tail_) == 1 ? N_STRIP + (nxt_ ? S_SPLIT : 0) : (nxt_ ? N_STRIP - S_SPLIT : 0)); \
        const int nI_ = (tail_) == 1 ? 0 : I_OUT, i0_ = 2 * I_IN + ((tail_) == 2 ? I_OUT : 0); \
        const int spS_ = nS_ * TAIL_SHARE / 256, spI_ = nI_ * TAIL_SHARE / 256; \
        const int ia_ = conv_ ? 0 : spI_, ib_ = conv_ ? spI_ : nI_, sa_ = conv_ ? 0 : spS_, sb_ = conv_ ? spS_ : nS_; \
        for (int it = i0_ + ia_ + w0_; it < i0_ + ib_; it += nw_) CONVERT_ITEM((l_), it); \
        for (int st = sa_ + cwi_; st < sb_; st += cwn_) TAIL_STRIP((l_), (tail_), st); } } while (0)
    {
        PHASE_BEGIN();
        LAS float* scr = (LAS float*)(F.lds + RING_OFF + wave * 16384);
        for (int st = vcu; st < N_STRIP; st += G_) CONVERT_STRIP(0, 0, st);
        for (int m = gw; m < MROWS; m += NGW) cast_row(m < SEQ ? x_in + (size_t)m * DM : mem + (size_t)(m - SEQ) * DM, Hb + (size_t)m * DM, rstd + m, lane, H8 + (size_t)m * DM, rs8 + m);
    }
    GRID_BAR();

#define QUANT_ROW(s_) do { { const v4u w_ = *((const GAS v4u*)(Cat + (size_t)(s_) * DM) + 192 + lane); \
            ov[3][0] = bf_lo(w_.x); ov[3][1] = bf_hi(w_.x); ov[3][2] = bf_lo(w_.y); ov[3][3] = bf_hi(w_.y); ov[3][4] = bf_lo(w_.z); ov[3][5] = bf_hi(w_.z); ov[3][6] = bf_lo(w_.w); ov[3][7] = bf_hi(w_.w); } \
        float mx_ = 0.f; \
        _Pragma("unroll") for (int a_ = 0; a_ < 4; ++a_) _Pragma("unroll") for (int e_ = 0; e_ < 8; ++e_) mx_ = fmaxf(mx_, fabsf(ov[a_][e_])); \
        mx_ = wave_max(mx_); const float inv_ = mx_ > 0.f ? 127.0f / mx_ : 0.f; \
        _Pragma("unroll") for (int a_ = 0; a_ < 4; ++a_) { v2u o_; o_.x = q8pack(ov[a_][0], ov[a_][1], ov[a_][2], ov[a_][3], inv_); o_.y = q8pack(ov[a_][4], ov[a_][5], ov[a_][6], ov[a_][7], inv_); \
            *((GAS v2u*)(Cat8 + (size_t)(s_) * DM) + lane + 64 * a_) = o_; } \
        if (lane == 0) cat_rs[(s_)] = mx_ * (1.0f / 127.0f); } while (0)
#ifndef DBG_MAXSUB
#define DBG_MAXSUB (3 * DEPTH)
#endif
#ifndef FUSE_THIN
#define FUSE_THIN 1
#endif
    const bool fuse = FUSE_THIN && gridDim.x == (SEQ / 256) * (DM / 256);
#define FUSED_EPI() pg8::EpiNormRes E{Hb, g_post + (size_t)(l * 3 + part) * DM, part == 1 ? 1.0f : 0.5f, (sub + 1 == 3 * DEPTH) ? X : nullptr, rstd, (unsigned*)(ws + WS_SLOT1), (unsigned*)(ws + WS_SLOT2), \
        ctl + CW_X1, ctl + CW_X2, 32u * (unsigned)(sub + 1), ctl + 2, DM, 1.0f / DM, RMS_EPS}
    for (int sub = 0; sub < DBG_MAXSUB; ++sub) {
        const int l = sub / 3, part = sub % 3;
        unsigned char* wl = ws + WS_W + (size_t)l * LW;
        if (part != 1) {
            const int half = part >> 1;
            {
                int cc = blockIdx.x, GG = gridDim.x; asm volatile("" : "+s"(cc), "+s"(GG));
                pg8::Gemm g{(const bf16*)H8, (const bf16*)(wl + LW_IN + (size_t)half * 44 * MiB), SEQ, 2 * DFF, DM / 2}; pg8::XOrder S; S.init(SEQ, 2 * DFF, GG, cc, 0);
                pg8::EpiSwiGLU8 E{Ab, DFF, rs8, (const float*)(wl + LW_IN + (size_t)half * 44 * MiB + 32 * MiB), (LAS float*)(F.lds + RSTAB_OFF), (LAS float*)(F.lds + CSTAB_OFF)};
                pg8::gemm_phase<pg8::EpiSwiGLU8, pg8::XOrder, true, true, true>(F.lds + RING_OFF, g, S, E);
            }
            TAIL_CONVERT(l, part, (SEQ / 256) * (2 * DFF / 256) % 256);
            GRID_BAR();
            {
                int cc = blockIdx.x, GG = gridDim.x; asm volatile("" : "+s"(cc), "+s"(GG));
                pg8::Gemm g{Ab, (const bf16*)(wl + LW_OUT + (size_t)half * 22 * MiB), SEQ, DM, DFF}; pg8::XOrder S; S.init(SEQ, DM, GG, cc, 0);
                if (fuse) { FUSED_EPI(); pg8::gemm_phase<pg8::EpiNormRes, pg8::XOrder, false, true>(F.lds + RING_OFF, g, S, E); }
                else { pg8::EpiBf16 E{Fb, DM, nullptr, (LAS float*)(F.lds + RSTAB_OFF)}; pg8::gemm_phase<pg8::EpiBf16, pg8::XOrder, true, true>(F.lds + RING_OFF, g, S, E); }
            }
        } else {
            {
                int cc = blockIdx.x, GG = gridDim.x; asm volatile("" : "+s"(cc), "+s"(GG));
                pg8::Gemm g{(const bf16*)H8, (const bf16*)(wl + LW_QKV), SEQ, IN_W, DM / 2}; pg8::XOrder S; S.init(SEQ, IN_W, GG, cc, KVW / 256);
                pg8::EpiBf16I8 E{Pb, LDP, rs8, (const float*)(wl + LW_QKV + 16 * MiB), (LAS float*)(F.lds + RSTAB_OFF), (LAS float*)(F.lds + CSTAB_OFF)};
                pg8::gemm_phase<pg8::EpiBf16I8, pg8::XOrder, true, true, true>(F.lds + RING_OFF, g, S, E);
            }
            TAIL_CONVERT(l, 1, ((SEQ / 256) * (IN_W / 256) + KVW / 256) % 256);
            GRID_BAR();
            float* lse = (float*)(ws + WS_LSE);
            if ((l & 1) == 0) {
                {
                    PHASE_BEGIN();
                    LAS float* red = (LAS float*)(F.lds + RING_OFF);
                    for (int it = bx_; it < NH * MOBA_NB; it += G_) { const int h = it / MOBA_NB, n = it % MOBA_NB;
                        const GAS unsigned* kp = (const GAS unsigned*)(Pb + (size_t)(n * MOBA_BLK + wave * 32) * LDP + KCOL + h * HD) + lane; unsigned wv[32];
#pragma unroll
                        for (int r = 0; r < 32; ++r) wv[r] = kp[(size_t)r * (LDP / 2)];
                        float a0 = 0.f, a1 = 0.f;
#pragma unroll
                        for (int r = 0; r < 32; ++r) { a0 += bf_lo(wv[r]); a1 += bf_hi(wv[r]); }
                        red[wave * HD + 2 * lane] = a0; red[wave * HD + 2 * lane + 1] = a1;
                        __syncthreads();
                        if (tid_ < HD) { float sacc = 0.f;
#pragma unroll
                            for (int w = 0; w < NWAVES; ++w) sacc += red[w * HD + tid_];
                            kmean[(size_t)it * HD + tid_] = sacc * (1.0f / MOBA_BLK); }
                        __syncthreads(); }
                }
                GRID_BAR();
                unsigned* mcnt = ctl + CW_CNT + (l >> 1) * (NH * MOBA_NB); unsigned* selm = (unsigned*)(ws + WS_SEL); float* plse = (float*)(ws + WS_PLSE); int* mlist = (int*)(ws + WS_LIST); bf16* part = (bf16*)(ws + WS_PART);
                {
                    int bx = blockIdx.x, GG = gridDim.x; asm volatile("" : "+s"(bx), "+s"(GG));
                    for (int i = 0; i * GG < NH * MOBA_NB; ++i) { const int u = (i & 1) ? (i + 1) * GG - 1 - bx : i * GG + bx;
                        if (u < NH * MOBA_NB) att::gate_unit(u % NH, MOBA_NB - 1 - u / NH, Pb, kmean, selm, plse, mcnt, mlist, (LAS char*)(F.lds + RING_OFF)); }
                }
                GRID_BAR();
                {
                    int tid_ = threadIdx.x; asm volatile("" : "+v"(tid_)); int bx = blockIdx.x, GG = gridDim.x; asm volatile("" : "+s"(bx), "+s"(GG));
                    const int tid = tid_, lane = tid & 63, wave = __builtin_amdgcn_readfirstlane(tid >> 6);
                    LAS char* alds = (LAS char*)(F.lds + RING_OFF);
                    LAS int* pre = (LAS int*)(alds + att::B_PRE);
                    if (tid < NH * MOBA_NB) { const int c = (int)__hip_atomic_load(mcnt + tid, __ATOMIC_RELAXED, __HIP_MEMORY_SCOPE_AGENT); pre[tid + 1] = (8 + ((c + 31) >> 5) + 7) >> 3; }
                    if (tid == 0) pre[0] = 0;
                    __syncthreads();
                    if (wave == 0) { int v[6], sum = 0;
#pragma unroll
                        for (int q = 0; q < 6; ++q) { v[q] = pre[1 + 6 * lane + q]; sum += v[q]; }
                        int x = sum;
#pragma unroll
                        for (int o = 1; o < 64; o <<= 1) { const int y = __shfl_up(x, o); if (lane >= o) x += y; }
                        int run = x - sum;
#pragma unroll
                        for (int q = 0; q < 6; ++q) { run += v[q]; pre[1 + 6 * lane + q] = run; } }
                    __syncthreads();
                    const int U_s = pre[NH * MOBA_NB], total = U_s + NMH * (SEQ / 32 / 8);
                    const int vbx = (GG % 8 == 0) ? (bx % 8) * (GG / 8) + bx / 8 : bx;
                    const int ulo = (int)((long)vbx * total / GG), uhi = (int)((long)(vbx + 1) * total / GG);
                    int un = ulo;
                    while (un < uhi) {
                        if (un < U_s) {
                            int lo = 0, hi2 = NH * MOBA_NB;
                            while (hi2 - lo > 1) { const int mid = (lo + hi2) >> 1; if (pre[mid] <= un) lo = mid; else hi2 = mid; }
                            const int h = lo >> 5, n = lo & 31, chunk = un - pre[lo], nun = pre[lo + 1] - pre[lo]; const int cntv = (int)__hip_atomic_load(mcnt + lo, __ATOMIC_RELAXED, __HIP_MEMORY_SCOPE_AGENT);
                            const int cend = (nun - chunk) < (uhi - un) ? nun : chunk + (uhi - un);
                            const int ng = 8 + ((cntv + 31) >> 5), g0 = 8 * chunk, g1 = ng < 8 * cend ? ng : 8 * cend;
                            att::block_unit<0>(h, n, g0, g1, cntv, mlist + (size_t)lo * SEQ, selm + (size_t)h * SEQ, Pb, part, plse, alds, slope_of(h) * (1.0f / SCALE));
                            un += cend - chunk;
                        } else { const int mu = un - U_s, hm = mu >> 5, c = mu & 31; const int cend = (32 - c) < (uhi - un) ? 32 : c + (uhi - un);
                            att::block_unit<1>(hm, 0, 8 * c, 8 * cend, 0, nullptr, nullptr, Pb, Cat, nullptr, alds, 0.f);
                            un += cend - c; }
                    }
                }
                GRID_BAR();
                {
                    PHASE_BEGIN();
                    for (int s = gw; s < SEQ; s += NGW) { float ov[4][8];
#pragma unroll
                        for (int kq = 0; kq < 3; ++kq) { const int c = lane + 64 * kq, h = c >> 4, cc = c & 15;
                            const f32x4 lv = *(const GAS f32x4*)(plse + ((size_t)s * NH + h) * 4);
                            const float mx = fmaxf(fmaxf(lv.x, lv.y), fmaxf(lv.z, lv.w)); float w0 = __expf(lv.x - mx), w1 = __expf(lv.y - mx), w2 = __expf(lv.z - mx), w3 = __expf(lv.w - mx);
                            const float ri = 1.0f / (w0 + w1 + w2 + w3); w0 *= ri; w1 *= ri; w2 *= ri; w3 *= ri;
                            const GAS v4u* pp = (const GAS v4u*)(part + ((size_t)s * NH + h) * 4 * HD) + cc;
                            const v4u p0 = pp[0], p1 = pp[16], p2 = pp[32], p3 = pp[48];
#define MIX(f) ((w0 > 0.f ? w0 * f(p0) : 0.f) + (w1 > 0.f ? w1 * f(p1) : 0.f) + (w2 > 0.f ? w2 * f(p2) : 0.f) + w3 * f(p3))
#define LOX(p) bf_lo(p.x)
#define HIX(p) bf_hi(p.x)
#define LOY(p) bf_lo(p.y)
#define HIY(p) bf_hi(p.y)
#define LOZ(p) bf_lo(p.z)
#define HIZ(p) bf_hi(p.z)
#define LOW(p) bf_lo(p.w)
#define HIW(p) bf_hi(p.w)
                            ov[kq][0] = MIX(LOX); ov[kq][1] = MIX(HIX); ov[kq][2] = MIX(LOY); ov[kq][3] = MIX(HIY); ov[kq][4] = MIX(LOZ); ov[kq][5] = MIX(HIZ); ov[kq][6] = MIX(LOW); ov[kq][7] = MIX(HIW);
#undef MIX
#undef LOX
#undef HIX
#undef LOY
#undef HIY
#undef LOZ
#undef HIZ
#undef LOW
#undef HIW
                        }
                        QUANT_ROW(s);
                    }
                }
            } else {
                {
                    int bx0 = blockIdx.x, GG0 = gridDim.x; asm volatile("" : "+s"(bx0), "+s"(GG0));
                    const int bx = (GG0 % 8 == 0) ? (bx0 % 8) * (GG0 / 8) + bx0 / 8 : bx0;
                    for (int i = 0; i < 2; ++i) {
                        const int du = i == 0 ? bx : (bx < 128 ? 256 + bx : -1);
                        if (du >= 0) { const int h = du >> 5, v = du & 31, gi = h >> 2, d = gi == 0 ? 1 : (gi == 1 ? 4 : 16), upr = 32 / d, r = v / upr, cp = v % upr;
                            att::UnitDesc u; u.qrow0 = (256 * cp) * d + r; u.qstride = d; u.qcol = QCOL + h * HD; u.kcol = KCOL + h * HD; u.vcol = VCOL + h * HD; u.ocol = h * HD; u.qidx0 = 256 * cp;
                            u.kidx0 = 256 * cp - 128; u.krow0 = r; u.kstride = d; u.t_begin = cp == 0 ? 2 : 0; u.t_end = 6; u.cbr = slope_of(h) * (float)d * (1.0f / SCALE); u.h = h;
                            att::attn_unit<att::DIL>(u, Pb, Cat, lse, (LAS char*)(F.lds + RING_OFF));
                        } else { const int mu = bx - 128, hm = mu >> 5, c = mu & 31;
                            att::block_unit<1>(hm, 0, 8 * c, 8 * c + 8, 0, nullptr, nullptr, Pb, Cat, nullptr, (LAS char*)(F.lds + RING_OFF), 0.f); }
                    }
                }
                GRID_BAR();
                {
                    PHASE_BEGIN();
                    for (int s = gw; s < SEQ; s += NGW) { float ov[4][8];
#pragma unroll
                        for (int k = 0; k < 3; ++k) { const int c = lane + 64 * k, h = c >> 4, j = h & 3;
                            const float l0 = lse[(size_t)s * NH + j], l1 = lse[(size_t)s * NH + 4 + j], l2 = lse[(size_t)s * NH + 8 + j], lh = lse[(size_t)s * NH + h];
                            const float mx = fmaxf(l0, fmaxf(l1, l2)); const float al = __expf(lh - mx) / (__expf(l0 - mx) + __expf(l1 - mx) + __expf(l2 - mx));
                            const v4u w = *((const GAS v4u*)(Cat + (size_t)s * DM) + c);
                            ov[k][0] = bf_lo(w.x) * al; ov[k][1] = bf_hi(w.x) * al; ov[k][2] = bf_lo(w.y) * al; ov[k][3] = bf_hi(w.y) * al; ov[k][4] = bf_lo(w.z) * al; ov[k][5] = bf_hi(w.z) * al; ov[k][6] = bf_lo(w.w) * al; ov[k][7] = bf_hi(w.w) * al; }
                        QUANT_ROW(s);
                    }
                }
            }
            GRID_BAR();
            {
                int cc = blockIdx.x, GG = gridDim.x; asm volatile("" : "+s"(cc), "+s"(GG));
                pg8::Gemm g{(const bf16*)Cat8, (const bf16*)(wl + LW_O), SEQ, DM, DM / 2}; pg8::XOrder S; S.init(SEQ, DM, GG, cc, 0);
                pg8::EpiBf16I8 E{Fb, DM, cat_rs, (const float*)(wl + LW_O + 6 * MiB), (LAS float*)(F.lds + RSTAB_OFF), (LAS float*)(F.lds + CSTAB_OFF)};
                pg8::gemm_phase<pg8::EpiBf16I8, pg8::XOrder, true, true, true>(F.lds + RING_OFF, g, S, E);
            }
        }
        if (!fuse) {
            GRID_BAR();
            PHASE_BEGIN();
            const float* gpo = g_post + (size_t)(l * 3 + part) * DM;
            const float coef = part == 1 ? 1.0f : 0.5f;
            const bool last = sub + 1 == 3 * DEPTH;
            for (int m = gw; m < SEQ; m += 2 * NGW) thin_rows<2>(Hb, Fb, gpo, coef, rstd, last ? X : nullptr, m, NGW, SEQ, lane, last ? nullptr : H8, rs8);
        }
        if (sub + 1 < 3 * DEPTH) GRID_BAR();
    }
}

extern "C" void kernel_launch(void* const* d_in, const int* in_sizes, int n_in, void* d_out, int out_size, void* d_ws, size_t ws_size, hipStream_t stream) {
    static int grid = 0;
    if (grid == 0) {
        if (n_in != 10 || in_sizes[0] != SEQ * DM || out_size != SEQ * DM || ws_size < WS_END) { fprintf(stderr, "kernel_launch: shape mismatch: n_in %d in0 %d out %d ws %zu (need %zu)\n", n_in, n_in > 0 ? in_sizes[0] : -1, out_size, ws_size, (size_t)WS_END); grid = -1; return; }
        int dev = 0, cus = 0, per_cu = 0;
        if (hipGetDevice(&dev) != hipSuccess || hipDeviceGetAttribute(&cus, hipDeviceAttributeMultiprocessorCount, dev) != hipSuccess) { fprintf(stderr, "kernel_launch: device query failed\n"); grid = -1; return; }
        if (hipFuncSetAttribute((const void*)trunk_fwd, hipFuncAttributeMaxDynamicSharedMemorySize, LDS_BYTES) != hipSuccess) { fprintf(stderr, "kernel_launch: hipFuncSetAttribute failed\n"); grid = -1; return; }
        if (hipOccupancyMaxActiveBlocksPerMultiprocessor(&per_cu, (const void*)trunk_fwd, NWAVES * 64, LDS_BYTES) != hipSuccess || per_cu < 1)
            fprintf(stderr, "kernel_launch: note: occupancy query reports %d workgroups per CU\n", per_cu);
        (void)hipGetLastError();
        grid = cus;
    }
    if (grid < 0) return;
    if (hipMemsetAsync((char*)d_ws + WS_CTL, 0, CTL_ZERO_BYTES, stream) != hipSuccess) { fprintf(stderr, "kernel_launch: memset failed\n"); return; }
    Args a{};
    for (int i = 0; i < 10; ++i) a.in[i] = (const float*)d_in[i];
    a.out = (float*)d_out; a.ws = (unsigned char*)d_ws;
    hipLaunchKernelGGL(trunk_fwd, dim3(grid), dim3(NWAVES * 64), LDS_BYTES, stream, a);
    const hipError_t le = hipPeekAtLastError();
    if (le != hipSuccess) fprintf(stderr, "kernel_launch: launch failed: %s\n", hipGetErrorName(le));
}
```
